# Optimizing an MI355X kernel written in HIP

```python
import math
import jax, jax.numpy as jnp
from jax import lax
import numpy as np

D_MODEL = 1024
BATCH = 8
SEQ = 4096
DEPTH = 1

SSM_WIDTH = D_MODEL // 2
SSM_GROUP = 16
SSM_GROUPS = SSM_WIDTH // SSM_GROUP
SSM_STATE = 64
DT_MIN = 1e-3
DT_MAX = 1e-1
MLA_HEADS = 8
MLA_NOPE = 64
MLA_ROPE = 32
MLA_V = 64
MLA_Q_LORA = 384
MLA_KV_LORA = 256
ROPE_THETA = 10000.0
Q_BLOCK = 128
N_BRANCHES = 2
IN_SPLITS = [SSM_WIDTH,
             SSM_WIDTH + MLA_Q_LORA,
             SSM_WIDTH + MLA_Q_LORA + MLA_KV_LORA,
             SSM_WIDTH + MLA_Q_LORA + MLA_KV_LORA + MLA_ROPE]
IN_WIDTH = SSM_WIDTH + MLA_Q_LORA + MLA_KV_LORA + MLA_ROPE + N_BRANCHES * D_MODEL
MEM_TOKENS = 256
MEM_HEADS = 4
MEM_HEAD_DIM = D_MODEL // MEM_HEADS
PEER_HEADS = 8
PEER_N_KEYS = 128
PEER_EXPERTS = PEER_N_KEYS * PEER_N_KEYS
PEER_KEY_DIM = 256
PEER_HALF = PEER_KEY_DIM // 2
PEER_TOPK = 16
PEER_TOKEN_BLOCK = 128
NORM_EPS = 1e-6

kernel_name = "hybrid_s5_mla_peer_encoder"


def rms_norm(x, g):
    xf = x.astype(jnp.float32)
    y = xf * lax.rsqrt(jnp.mean(xf * xf, axis=-1, keepdims=True) + NORM_EPS)
    return (y * g.astype(jnp.float32)).astype(x.dtype)


def rope_tables(positions):
    inv_freq = 1.0 / (ROPE_THETA ** (jnp.arange(0, MLA_ROPE, 2, dtype=jnp.float32) / MLA_ROPE))
    ang = positions.astype(jnp.float32)[..., None] * inv_freq
    return jnp.cos(ang), jnp.sin(ang)


def apply_rope(t, cos, sin):
    t1, t2 = jnp.split(t, 2, axis=-1)
    cos = cos.astype(t.dtype)
    sin = sin.astype(t.dtype)
    return jnp.concatenate([t1 * cos - t2 * sin, t2 * cos + t1 * sin], axis=-1)


def _complex_linear_combine(left, right):
    ar1, ai1, br1, bi1 = left
    ar2, ai2, br2, bi2 = right
    ar = ar2 * ar1 - ai2 * ai1
    ai = ar2 * ai1 + ai2 * ar1
    br = ar2 * br1 - ai2 * bi1 + br2
    bi = ar2 * bi1 + ai2 * br1 + bi2
    return (ar, ai, br, bi)


def s5_direction(u, lam_re, lam_im, log_dt, b_re, b_im, c_re, c_im, reverse):
    f32 = jnp.float32
    lam_re = lam_re.astype(f32); lam_im = lam_im.astype(f32)
    dt = jnp.exp(log_dt.astype(f32))[:, None]
    mag = jnp.exp(lam_re * dt)
    ar = mag * jnp.cos(lam_im * dt)
    ai = mag * jnp.sin(lam_im * dt)
    nr = ar - 1.0
    den = lam_re * lam_re + lam_im * lam_im
    fr = (nr * lam_re + ai * lam_im) / den
    fi = (ai * lam_re - nr * lam_im) / den
    b_re = b_re.astype(f32); b_im = b_im.astype(f32)
    bb_re = fr[..., None] * b_re - fi[..., None] * b_im
    bb_im = fr[..., None] * b_im + fi[..., None] * b_re
    bu_re = jnp.einsum('blgc,gpc->blgp', u, bb_re)
    bu_im = jnp.einsum('blgc,gpc->blgp', u, bb_im)
    L = u.shape[1]
    a_re = jnp.broadcast_to(ar[None, None], (1, L) + ar.shape)
    a_im = jnp.broadcast_to(ai[None, None], (1, L) + ai.shape)
    _, _, s_re, s_im = lax.associative_scan(
        _complex_linear_combine, (a_re, a_im, bu_re, bu_im), reverse=reverse, axis=1)
    return (jnp.einsum('blgp,gcp->blgc', s_re, c_re.astype(f32))
            - jnp.einsum('blgp,gcp->blgc', s_im, c_im.astype(f32)))


def mla_attention(q_nope, q_rope, k_nope, k_rope, v):
    Bsz, L, H, _ = q_nope.shape
    nb = L // Q_BLOCK
    scale = (MLA_NOPE + MLA_ROPE) ** -0.5

    def to_blocks(t):
        return jnp.moveaxis(t.reshape((Bsz, nb, Q_BLOCK) + t.shape[2:]), 1, 0)

    def block(qs):
        qn, qr = qs
        s = (jnp.einsum('bqhd,bkhd->bhqk', qn, k_nope, preferred_element_type=jnp.float32)
             + jnp.einsum('bqhr,bkr->bhqk', qr, k_rope, preferred_element_type=jnp.float32)) * scale
        p = jax.nn.softmax(s, axis=-1).astype(v.dtype)
        return jnp.einsum('bhqk,bkhd->bqhd', p, v)

    o = lax.map(block, (to_blocks(q_nope), to_blocks(q_rope)))
    return jnp.moveaxis(o, 0, 1).reshape(Bsz, L, H * MLA_V)


def mixer_block(xn, cos, sin, w_in, b_gate, lam_re, lam_im, log_dt, b_re, b_im, c_re, c_im,
                d_skip, w_ssm_glu, g_q_lora, w_uq, g_kv_lora, w_ukv, w_mla_o, w_out):
    Bsz, L, _ = xn.shape
    proj = xn @ w_in
    u_ssm, c_q, c_kv, k_rope, gate_logits = jnp.split(proj, IN_SPLITS, axis=-1)

    u = u_ssm.reshape(Bsz, L, SSM_GROUPS, SSM_GROUP).astype(jnp.float32)
    y = (s5_direction(u, lam_re[0], lam_im[0], log_dt[0], b_re[0], b_im[0], c_re[0], c_im[0], False)
         + s5_direction(u, lam_re[1], lam_im[1], log_dt[1], b_re[1], b_im[1], c_re[1], c_im[1], True))
    y = y.reshape(Bsz, L, SSM_WIDTH) + d_skip.astype(jnp.float32) * u_ssm.astype(jnp.float32)
    y = jax.nn.gelu(y).astype(xn.dtype)
    glu_val, glu_gate = jnp.split(y @ w_ssm_glu, 2, axis=-1)
    branch_ssm = glu_val * jax.nn.sigmoid(glu_gate)

    c_q = rms_norm(c_q, g_q_lora)
    q = (c_q @ w_uq).reshape(Bsz, L, MLA_HEADS, MLA_NOPE + MLA_ROPE)
    q_nope = q[..., :MLA_NOPE]
    q_rope = apply_rope(q[..., MLA_NOPE:], cos[:, :, None], sin[:, :, None])
    c_kv = rms_norm(c_kv, g_kv_lora)
    kv = (c_kv @ w_ukv).reshape(Bsz, L, MLA_HEADS, MLA_NOPE + MLA_V)
    k_nope = kv[..., :MLA_NOPE]
    v = kv[..., MLA_NOPE:]
    k_rope = apply_rope(k_rope, cos, sin)
    branch_mla = mla_attention(q_nope, q_rope, k_nope, k_rope, v) @ w_mla_o

    gates = jax.nn.sigmoid((gate_logits + b_gate).astype(jnp.float32)).astype(xn.dtype)
    g_ssm, g_mla = jnp.split(gates, N_BRANCHES, axis=-1)
    return (g_ssm * branch_ssm + g_mla * branch_mla) @ w_out


def memory_cross_attention(hn, memn, w_q, w_kv, w_o):
    Bsz, L, _ = hn.shape
    M = memn.shape[1]
    q = (hn @ w_q).reshape(Bsz, L, MEM_HEADS, MEM_HEAD_DIM)
    k, v = jnp.split(memn @ w_kv, 2, axis=-1)
    k = k.reshape(Bsz, M, MEM_HEADS, MEM_HEAD_DIM)
    v = v.reshape(Bsz, M, MEM_HEADS, MEM_HEAD_DIM)
    s = jnp.einsum('blhd,bmhd->bhlm', q, k, preferred_element_type=jnp.float32) * (MEM_HEAD_DIM ** -0.5)
    p = jax.nn.softmax(s, axis=-1).astype(v.dtype)
    o = jnp.einsum('bhlm,bmhd->blhd', p, v).reshape(Bsz, L, D_MODEL)
    return o @ w_o


def peer_ffn(hn, w_q, sub_keys, u_emb, v_emb):
    Bsz, L, D = hn.shape
    tokens = hn.reshape(-1, PEER_TOKEN_BLOCK, D)

    def block(xc):
        T = xc.shape[0]
        q = (xc @ w_q).reshape(T, PEER_HEADS, 2, PEER_HALF)
        s = jnp.einsum('thsd,hsnd->thsn', q, sub_keys, preferred_element_type=jnp.float32)
        s1, i1 = lax.top_k(s[:, :, 0], PEER_TOPK)
        s2, i2 = lax.top_k(s[:, :, 1], PEER_TOPK)
        cand_s = (s1[..., :, None] + s2[..., None, :]).reshape(T, PEER_HEADS, PEER_TOPK * PEER_TOPK)
        cand_i = (i1[..., :, None] * PEER_N_KEYS + i2[..., None, :]).reshape(T, PEER_HEADS, PEER_TOPK * PEER_TOPK)
        top_s, pos = lax.top_k(cand_s, PEER_TOPK)
        idx = jnp.take_along_axis(cand_i, pos, axis=-1)
        gate = jax.nn.softmax(top_s, axis=-1)
        u = jnp.take(u_emb, idx, axis=0)
        act = jax.nn.gelu(jnp.einsum('thkd,td->thk', u, xc).astype(jnp.float32))
        vv = jnp.take(v_emb, idx, axis=0)
        return jnp.einsum('thk,thkd->td', (gate * act).astype(vv.dtype), vv)

    return lax.map(block, tokens).reshape(Bsz, L, D)


def setup_inputs(seed: int = 0) -> dict:
    key = jax.random.key(seed)
    ks = iter(jax.random.split(key, 48))

    def nrm(shape, std):
        return std * jax.random.normal(next(ks), shape, jnp.float32)

    def gain(shape):
        return 1.0 + nrm(shape, 0.02)

    G, P, Cg = SSM_GROUPS, SSM_STATE, SSM_GROUP
    x = nrm((BATCH, SEQ, D_MODEL), 1.0)
    mem = nrm((BATCH, MEM_TOKENS, D_MODEL), 1.0)
    positions = jnp.broadcast_to(jnp.arange(SEQ, dtype=jnp.int32)[None, :], (BATCH, SEQ))
    g_mix = gain((DEPTH, D_MODEL))
    w_in = nrm((DEPTH, D_MODEL, IN_WIDTH), D_MODEL ** -0.5)
    b_gate = nrm((DEPTH, N_BRANCHES * D_MODEL), 0.02)
    ssm_lam_re = -0.5 + nrm((DEPTH, 2, G, P), 0.01)
    ssm_lam_im = math.pi * jnp.arange(P, dtype=jnp.float32) + nrm((DEPTH, 2, G, P), 0.01)
    ssm_log_dt = jax.random.uniform(next(ks), (DEPTH, 2, G), jnp.float32,
                                    math.log(DT_MIN), math.log(DT_MAX))
    ssm_b_re = nrm((DEPTH, 2, G, P, Cg), (2 * Cg) ** -0.5)
    ssm_b_im = nrm((DEPTH, 2, G, P, Cg), (2 * Cg) ** -0.5)
    ssm_c_re = nrm((DEPTH, 2, G, Cg, P), P ** -0.5)
    ssm_c_im = nrm((DEPTH, 2, G, Cg, P), P ** -0.5)
    ssm_d = nrm((DEPTH, SSM_WIDTH), 1.0)
    w_ssm_glu = nrm((DEPTH, SSM_WIDTH, 2 * D_MODEL), SSM_WIDTH ** -0.5)
    g_q_lora = gain((DEPTH, MLA_Q_LORA))
    w_uq = nrm((DEPTH, MLA_Q_LORA, MLA_HEADS * (MLA_NOPE + MLA_ROPE)), MLA_Q_LORA ** -0.5)
    g_kv_lora = gain((DEPTH, MLA_KV_LORA))
    w_ukv = nrm((DEPTH, MLA_KV_LORA, MLA_HEADS * (MLA_NOPE + MLA_V)), MLA_KV_LORA ** -0.5)
    w_mla_o = nrm((DEPTH, MLA_HEADS * MLA_V, D_MODEL), (MLA_HEADS * MLA_V) ** -0.5)
    w_out = nrm((DEPTH, D_MODEL, D_MODEL), D_MODEL ** -0.5)
    g_mem_q = gain((DEPTH, D_MODEL))
    g_mem_kv = gain((DEPTH, D_MODEL))
    w_mem_q = nrm((DEPTH, D_MODEL, D_MODEL), D_MODEL ** -0.5)
    w_mem_kv = nrm((DEPTH, D_MODEL, 2 * D_MODEL), D_MODEL ** -0.5)
    w_mem_o = nrm((DEPTH, D_MODEL, D_MODEL), D_MODEL ** -0.5)
    g_peer = gain((DEPTH, D_MODEL))
    w_peer_q = nrm((DEPTH, D_MODEL, PEER_HEADS * PEER_KEY_DIM), D_MODEL ** -0.5)
    peer_sub_keys = nrm((DEPTH, PEER_HEADS, 2, PEER_N_KEYS, PEER_HALF), PEER_HALF ** -0.5)
    peer_u = nrm((DEPTH, PEER_EXPERTS, D_MODEL), D_MODEL ** -0.5)
    peer_v = nrm((DEPTH, PEER_EXPERTS, D_MODEL), PEER_HEADS ** -0.5)
    g_final = gain((D_MODEL,))
    return {"x": x, "mem": mem, "positions": positions, "g_mix": g_mix, "w_in": w_in,
            "b_gate": b_gate, "ssm_lam_re": ssm_lam_re, "ssm_lam_im": ssm_lam_im,
            "ssm_log_dt": ssm_log_dt, "ssm_b_re": ssm_b_re, "ssm_b_im": ssm_b_im,
            "ssm_c_re": ssm_c_re, "ssm_c_im": ssm_c_im, "ssm_d": ssm_d, "w_ssm_glu": w_ssm_glu,
            "g_q_lora": g_q_lora, "w_uq": w_uq, "g_kv_lora": g_kv_lora, "w_ukv": w_ukv,
            "w_mla_o": w_mla_o, "w_out": w_out, "g_mem_q": g_mem_q, "g_mem_kv": g_mem_kv,
            "w_mem_q": w_mem_q, "w_mem_kv": w_mem_kv, "w_mem_o": w_mem_o, "g_peer": g_peer,
            "w_peer_q": w_peer_q, "peer_sub_keys": peer_sub_keys, "peer_u": peer_u,
            "peer_v": peer_v, "g_final": g_final}


def reference(x, mem, positions, g_mix, w_in, b_gate, ssm_lam_re, ssm_lam_im, ssm_log_dt,
              ssm_b_re, ssm_b_im, ssm_c_re, ssm_c_im, ssm_d, w_ssm_glu, g_q_lora, w_uq,
              g_kv_lora, w_ukv, w_mla_o, w_out, g_mem_q, g_mem_kv, w_mem_q, w_mem_kv, w_mem_o,
              g_peer, w_peer_q, peer_sub_keys, peer_u, peer_v, g_final):
    cos, sin = rope_tables(positions)
    h = x
    for l in range(DEPTH):
        h = h + mixer_block(rms_norm(h, g_mix[l]), cos, sin, w_in[l], b_gate[l],
                            ssm_lam_re[l], ssm_lam_im[l], ssm_log_dt[l], ssm_b_re[l], ssm_b_im[l],
                            ssm_c_re[l], ssm_c_im[l], ssm_d[l], w_ssm_glu[l], g_q_lora[l], w_uq[l],
                            g_kv_lora[l], w_ukv[l], w_mla_o[l], w_out[l])
        h = h + memory_cross_attention(rms_norm(h, g_mem_q[l]), rms_norm(mem, g_mem_kv[l]),
                                       w_mem_q[l], w_mem_kv[l], w_mem_o[l])
        h = h + peer_ffn(rms_norm(h, g_peer[l]), w_peer_q[l], peer_sub_keys[l], peer_u[l], peer_v[l])
    return rms_norm(h, g_final)
```

```cpp
#include <hip/hip_runtime.h>
#include <hip/hip_bf16.h>
#include <cstdio>
#include <cstdint>

#ifndef REP
#define REP 0
#endif
#ifndef PRO_REP
#define PRO_REP 0
#endif
#ifndef REPG
#define REPG -1
#endif
#ifndef DEBUG_STAGE
#define DEBUG_STAGE 9
#endif

constexpr int D = 1024, BATCH = 8, SEQ = 4096, NTOK = BATCH * SEQ;
constexpr int MEMT = 256, NMEM = BATCH * MEMT;
constexpr int TCH = 32;
constexpr int NCHUNK = NTOK / TCH;
constexpr int UPITCH = 768;
constexpr float EPS = 1e-6f;

#define GAS __attribute__((address_space(1)))
#define LAS __attribute__((address_space(3)))
typedef unsigned short bf16;
typedef unsigned v4u __attribute__((ext_vector_type(4)));
typedef unsigned v2u __attribute__((ext_vector_type(2)));
typedef float f32x4 __attribute__((ext_vector_type(4)));
typedef float f32x2 __attribute__((ext_vector_type(2)));
typedef short bf16x8 __attribute__((ext_vector_type(8)));
typedef GAS unsigned gu32;
typedef _Float16 h2_t __attribute__((ext_vector_type(2)));
__device__ __forceinline__ unsigned pkh2(float a, float b) { h2_t h = {(_Float16)a, (_Float16)b}; return __builtin_bit_cast(unsigned, h); }
__device__ __forceinline__ void sincos_rev(float x, float& sn, float& cs) { float r = x * 0.15915494309189535f; r = r - floorf(r); sn = __builtin_amdgcn_sinf(r); cs = __builtin_amdgcn_cosf(r); }
#define RLX_AGENT __ATOMIC_RELAXED, __HIP_MEMORY_SCOPE_AGENT
#define LDS_WAIT() asm volatile("s_waitcnt lgkmcnt(0)" ::: "memory")
#define VM_WAIT() asm volatile("s_waitcnt vmcnt(0)" ::: "memory")

__device__ __forceinline__ unsigned f2bf(float f) { unsigned u = __builtin_bit_cast(unsigned, f); return (u + 0x7fffu + ((u >> 16) & 1u)) >> 16; }
typedef float f32x2_t_ __attribute__((ext_vector_type(2))); typedef __bf16 bf16x2_t_ __attribute__((ext_vector_type(2)));
__device__ __forceinline__ unsigned pk2(float lo, float hi) { const f32x2_t_ v = {lo, hi}; const bf16x2_t_ b = __builtin_convertvector(v, bf16x2_t_); return __builtin_bit_cast(unsigned, b); }
__device__ __forceinline__ float bf_lo(unsigned w) { return __builtin_bit_cast(float, w << 16); }
__device__ __forceinline__ float bf_hi(unsigned w) { return __builtin_bit_cast(float, w & 0xffff0000u); }
__device__ __forceinline__ float wave_sum(float v) {
#pragma unroll
    for (int o = 1; o < 64; o <<= 1) v += __shfl_xor(v, o);
    return v;
}
typedef unsigned long long u64;
__device__ __forceinline__ void fx_add(u64* p, float s) { atomicAdd(p, (u64)(long long)(s * 1073741824.0f)); }
__device__ __forceinline__ float fx_get(const u64* p) { return (float)(long long)(*p) * (1.0f / 1073741824.0f); }
__device__ __forceinline__ float sigmoidf_(float x) { return __builtin_amdgcn_rcpf(1.0f + __builtin_amdgcn_exp2f(-1.4426950408889634f * x)); }
__device__ __forceinline__ float gelu_tanh(float x) {
    const float u = 1.5957691216057308f * (x + 0.044715f * x * x * x);
    return x * __builtin_amdgcn_rcpf(1.0f + __builtin_amdgcn_exp2f(-1.4426950408889634f * u));
}

constexpr size_t MiB = 1u << 20;
constexpr size_t WS_CTL = 0;
constexpr size_t CTL_ZERO_BYTES = 4 * MiB;
constexpr size_t WS_SSQQ = 1 * MiB, WS_SSQKV = WS_SSQQ + 256 * 1024, WS_SSQ1 = WS_SSQKV + 256 * 1024, WS_SSQ2 = WS_SSQ1 + 256 * 1024;
constexpr size_t WS_ROWSUM = 2 * MiB;
constexpr size_t W_SK = 4 * MiB;
constexpr size_t W_PQN = 5 * MiB;
constexpr size_t W_MO2 = 9 * MiB;
constexpr size_t WS_TAB = 11 * MiB;
constexpr size_t W_IN = 15 * MiB;
constexpr size_t W_GLU = W_IN + (size_t)3328 * 1024 * 2;
constexpr size_t W_UQ = W_GLU + (size_t)2048 * 512 * 2;
constexpr size_t W_UKV = W_UQ + (size_t)768 * 384 * 2;
constexpr size_t W_MO = W_UKV + (size_t)1024 * 256 * 2;
constexpr size_t W_OUT = W_MO + (size_t)1024 * 512 * 2;
constexpr size_t W_MQN = W_OUT + (size_t)1024 * 1024 * 2;
constexpr size_t W_MKV = W_MQN + (size_t)1024 * 1024 * 2;
constexpr size_t W_END = W_MKV + (size_t)2048 * 1024 * 2;
static_assert(W_END <= 34 * MiB, "weights region");
constexpr size_t WS_PU4 = 12 * MiB;
constexpr size_t WS_TSC = 512 * 1024;
constexpr size_t WS_H8 = 110 * MiB;
constexpr float U4_STEP = 0.335f, H8_SCALE = 127.0f / 12.0f;
constexpr size_t WS_PV4 = 28 * MiB;
constexpr size_t WS_W1 = 494 * MiB;
constexpr size_t WS_W2 = 446 * MiB;
constexpr size_t WS_W3 = 462 * MiB;
constexpr size_t WS_KM = 34 * MiB, WS_VT = 38 * MiB, WS_MEMN = 42 * MiB;
constexpr size_t WS_DYN = 46 * MiB;
constexpr size_t WS_GATES = 46 * MiB;
constexpr size_t WS_MFULL = 174 * MiB;
constexpr size_t WS_WST = 198 * MiB;
constexpr size_t WS_U = 206 * MiB;
constexpr size_t WS_Q = 254 * MiB;
constexpr size_t WS_K = 302 * MiB;
constexpr size_t WS_V = 350 * MiB;
constexpr size_t WS_XN = 382 * MiB;
constexpr size_t WS_SLOC = 382 * MiB;
constexpr size_t WS_ATT = 382 * MiB;
constexpr size_t WS_YS = 414 * MiB;
constexpr size_t WS_CQ = 446 * MiB;
constexpr size_t WS_CKV = 470 * MiB;
constexpr size_t WS_MERGED = 254 * MiB;
constexpr size_t WS_H = 46 * MiB;
constexpr size_t WS_HB = 174 * MiB;
constexpr size_t WS_QM = 318 * MiB;
constexpr size_t WS_PM = 382 * MiB;
constexpr size_t WS_OM = 238 * MiB;
constexpr size_t WS_SC = 366 * MiB;
constexpr size_t WS_SELI = 238 * MiB;
constexpr size_t WS_SELG = 254 * MiB;
constexpr size_t WS_SELW = 270 * MiB;
constexpr size_t WS_WSC = 278 * MiB;
constexpr size_t WS_PART = 286 * MiB;
constexpr size_t WS_POUT = 286 * MiB;
constexpr size_t WS_END = 512 * MiB;
static_assert(WS_W1 + 4 * MiB <= WS_END && WS_SC + (size_t)NTOK * 2048 * 2 <= WS_W1 && WS_CKV + (size_t)NTOK * 256 * 2 <= WS_END && WS_POUT + (size_t)NTOK * 4096 <= WS_END, "ws map");

constexpr int CW_BAR = 4096;

constexpr int RING_BYTES = 131072;
constexpr int LDSCTL_OFF = RING_BYTES, MISC_OFF = LDSCTL_OFF + 320;
constexpr int LDS_BYTES = 147456;
constexpr int NWAVES = 8;

#define XB_TMO      128
#define XB_XCNT(j)  (256  + 64 * (j))
#define XB_XSUB(j)  (1280 + 64 * (j))
#define XB_XGEN(j)  (2304 + 64 * (j))
#define XB_TOP      3328
#define XB_TOPGEN   3392
#define XCD_BAR_WORDS 3456
#define XB_SPIN_CAP (1u << 20)
__device__ __forceinline__ unsigned xb_ld(unsigned* p)              { return __hip_atomic_load(p, __ATOMIC_RELAXED, __HIP_MEMORY_SCOPE_AGENT); }
__device__ __forceinline__ unsigned xb_add(unsigned* p, unsigned v) { return __hip_atomic_fetch_add(p, v, __ATOMIC_RELAXED, __HIP_MEMORY_SCOPE_AGENT); }
__device__ __forceinline__ unsigned xb_xcc_id() { return (unsigned)__builtin_amdgcn_s_getreg((3 << 11) | 20) & 0xFu; }
#define XB_SPIN(cond, bar) do { unsigned _sp = 0; while (cond) { __builtin_amdgcn_s_sleep(1); \
    if ((++_sp & 255u) == 0u) { if (xb_ld(&(bar)[XB_TMO])) break; if (_sp > XB_SPIN_CAP) { atomicAdd(&(bar)[XB_TMO], 1u); break; } } } } while (0)
struct XcdBarrier { unsigned* bar; unsigned x; volatile LAS unsigned* st; };
__device__ __forceinline__ XcdBarrier xcd_barrier_post(unsigned* bar, volatile LAS unsigned* st) {
    XcdBarrier b; b.bar = bar; b.x = xb_xcc_id(); b.st = st;
    if (threadIdx.x == 0) (void)xb_add(&bar[XB_XCNT(b.x)], 1u);
    return b;
}
__device__ __forceinline__ void xcd_barrier_complete(unsigned* bar, unsigned x, unsigned& nloc, unsigned& nx) {
    const unsigned G = gridDim.x * gridDim.y * gridDim.z;
    unsigned sum, cnt, mine, sp = 0u;
    for (;;) {
        sum = 0u; cnt = 0u; mine = 0u;
#pragma unroll
        for (unsigned j = 0; j < 16; ++j) { const unsigned c = xb_ld(&bar[XB_XCNT(j)]); sum += c; cnt += (c > 0u) ? 1u : 0u; mine = (j == x) ? c : mine; }
        if (sum == G) break;
        __builtin_amdgcn_s_sleep(1);
        if ((++sp & 255u) == 0u) { if (xb_ld(&bar[XB_TMO])) break; if (sp > XB_SPIN_CAP) { atomicAdd(&bar[XB_TMO], 1u); break; } }
    }
    nloc = mine > 0u ? mine : 1u; nx = cnt > 0u ? cnt : 1u;
}
__device__ __forceinline__ void xcd_barrier(const XcdBarrier& b) {
    asm volatile("s_waitcnt vmcnt(0)" ::: "memory");
    __syncthreads();
    if (threadIdx.x == 0) {
        unsigned* bar = b.bar;
        __builtin_amdgcn_s_waitcnt(0);
        unsigned nloc = b.st[0], nx = b.st[1];
        if (nloc == 0u) { xcd_barrier_complete(bar, b.x, nloc, nx); b.st[0] = nloc; b.st[1] = nx; }
        const unsigned old = xb_add(&bar[XB_XSUB(b.x)], 1u);
        const unsigned gen = old / nloc;
        if (old + 1u == (gen + 1u) * nloc) {
            __builtin_amdgcn_fence(__ATOMIC_RELEASE, "agent");
            asm volatile("s_waitcnt vmcnt(0)" ::: "memory");
            const unsigned og = xb_add(&bar[XB_TOP], 1u);
            const unsigned tg = og / nx;
            if (og + 1u == (tg + 1u) * nx) xb_add(&bar[XB_TOPGEN], 1u);
            else XB_SPIN(xb_ld(&bar[XB_TOPGEN]) == tg, bar);
            __builtin_amdgcn_fence(__ATOMIC_ACQUIRE, "agent");
            xb_add(&bar[XB_XGEN(b.x)], 1u);
            asm volatile("s_waitcnt vmcnt(0)" ::: "memory");
        } else {
            XB_SPIN(xb_ld(&bar[XB_XGEN(b.x)]) == gen, bar);
            __builtin_amdgcn_fence(__ATOMIC_ACQUIRE, "agent");
            asm volatile("s_waitcnt vmcnt(0)" ::: "memory");
        }
    }
    __syncthreads();
}

struct EpiArgs {
    unsigned char* ws;
    const float *b_gate, *x, *lam_re, *lam_im, *log_dt;
#define EP(name, type, off) __device__ __forceinline__ type* name() const { return (type*)(ws + (off)); }
    EP(U, bf16, WS_U) EP(CQ, bf16, WS_CQ) EP(CKV, bf16, WS_CKV) EP(Kb, bf16, WS_K) EP(Vb, bf16, WS_V) EP(Qb, bf16, WS_Q) EP(GATES, unsigned char, WS_GATES)
    EP(KM, bf16, WS_KM) EP(VT, bf16, WS_VT) EP(YS, bf16, WS_YS) EP(ATT, bf16, WS_ATT) EP(MERGED, bf16, WS_MERGED) EP(HB, bf16, WS_HB)
    EP(PM, bf16, WS_PM) EP(H8, unsigned char, WS_H8) EP(SC, _Float16, WS_SC) EP(W1, bf16, WS_W1) EP(W2, bf16, WS_W2) EP(W3, bf16, WS_W3)
    EP(ssq_q, u64, WS_SSQQ) EP(ssq_kv, u64, WS_SSQKV) EP(ssq1, u64, WS_SSQ1) EP(ssq2, u64, WS_SSQ2) EP(rowsum, u64, WS_ROWSUM) EP(SLOC, float, WS_SLOC) EP(H, float, WS_H)
    EP(tab, const f32x2, WS_TAB)
#undef EP
};

namespace pg8 {
#define PG8_LAS __attribute__((address_space(3)))
typedef unsigned short bf16_t;
typedef unsigned u32x4 __attribute__((ext_vector_type(4)));
constexpr int BM = 256, BK = 64, HALF = 128, HTB = HALF * BK * 2, STAGE_BYTES = 8 * HTB, NXCD = 8, WGM = 8;
constexpr int XCH_OFF_ = STAGE_BYTES + 1024;
__host__ __device__ __forceinline__ int lds_byte(int r, int c) { const int st = (r >> 4) * 2 + (c >> 5), rr = r & 15, cc = c & 31, ob = rr * 64 + cc * 2; return st * 1024 + (ob ^ (((ob >> 9) & 1) << 5)); }
__host__ __device__ __forceinline__ void stage_rc(int b, int& R, int& C) { const int st = b / 1024, sb = b % 1024, swz = sb ^ (((sb >> 9) & 1) << 5); R = (st >> 1) * 16 + swz / 64; C = (st & 1) * 32 + (swz % 64) / 2; }
__host__ __device__ __forceinline__ int perm32(int rho) { const int n = rho >> 4, i = rho & 15; return 8 * (i >> 2) + 4 * n + (i & 3); }

struct Unit { int pm, pn, z; };
enum { ORD_STD = 0, ORD_Z = 1, ORD_DUAL = 2 };
enum { EK_IN = 0, EK_MEMKV, EK_Q, EK_KV, EK_SLOC, EK_Y, EK_P4, EK_OUT, EK_MS2, EK_MO, EK_PS2, EK_W1, EK_W2, EK_W3 };
struct GemmDesc {
    const bf16_t *A0, *A1, *B0, *B1;
    int lda, ldb, K;
    int nM, nN, nZ, order, epi, after_drain;
    long sAz, sBz, sBb;
    __device__ __forceinline__ const char* aptr(const Unit& u) const {
        const bf16_t* a = (order == ORD_DUAL && u.z) ? A1 : A0;
        return (const char*)(a + ((order == ORD_DUAL) ? 0 : (long)u.z * sAz) + (long)u.pm * BM * lda); }
    __device__ __forceinline__ const char* bptr(const Unit& u) const {
        const bf16_t* b = (order == ORD_DUAL && u.z) ? B1 : B0;
        return (const char*)(b + ((order == ORD_DUAL) ? 0 : (long)u.z * sBz) + (long)(u.pm >> 4) * sBb + (long)u.pn * BM * ldb); }
    __device__ __forceinline__ bool next(int i, int G, int c, Unit& u) const {
        if (order == ORD_STD) {
            const int nwg = nM * nN; const long L = (long)i * G + c; if (L >= nwg) return false;
            int wgid = (int)L; { const int q = nwg / NXCD, r = nwg % NXCD, xcd = wgid % NXCD, off = wgid / NXCD; wgid = (xcd < r ? xcd * (q + 1) : r * (q + 1) + (xcd - r) * q) + off; }
            const int nig = WGM * nN, gid = wgid / nig, fm = gid * WGM, gsz = (nM - fm) < WGM ? (nM - fm) : WGM;
            u.pm = fm + ((wgid % nig) % gsz); u.pn = (wgid % nig) / gsz; u.z = 0; return true;
        } else if (order == ORD_Z) {
            const long L = (long)i * G + c; if (L >= (long)nZ * nM * nN) return false;
            const int l = (int)L; u.pn = l % nN; const int t = l / nN; u.pm = t % nM; u.z = t / nM; return true;
        } else {
            const int combos = nM * nN, combo = (i / 3) * G + c; if (combo >= combos) return false;
            const int sub = i % 3, pnp = combo / nM; u.pm = combo % nM;
            if (sub < 2) { u.pn = 2 * pnp + sub; u.z = 0; } else { u.pn = pnp; u.z = 1; }
            return true;
        }
    }
};

typedef f32x4 Acc[2][2][4][2];
__device__ __forceinline__ v4u pack8(const float* v) { v4u w; w.x = pk2(v[0], v[1]); w.y = pk2(v[2], v[3]); w.z = pk2(v[4], v[5]); w.w = pk2(v[6], v[7]); return w; }
#define LOADV(v, ai, bj, m) do { const f32x4 a_ = acc[ai][bj][m][0], b_ = acc[ai][bj][m][1]; v[0] = a_[0]; v[1] = a_[1]; v[2] = a_[2]; v[3] = a_[3]; v[4] = b_[0]; v[5] = b_[1]; v[6] = b_[2]; v[7] = b_[3]; } while (0)
__device__ __forceinline__ float quad_sum16(float s) { s += __shfl_xor(s, 16); s += __shfl_xor(s, 32); return s; }

__device__ __forceinline__ void rope8(float* v, const f32x2* tabrow, int fq) {
    const int ib = 8 * (fq & 1);
#pragma unroll
    for (int j = 0; j < 8; ++j) {
        const float other = __shfl_xor(v[j], 32);
        const f32x2 cs = tabrow[ib + j];
        v[j] = (fq < 2) ? (v[j] * cs.x - other * cs.y) : (v[j] * cs.x + other * cs.y);
    }
}

__device__ __forceinline__ void epilogue(const GemmDesc& g, const EpiArgs& E, const Acc& acc, const Unit& u, int wr, int wc, int fr, int fq, bool probe = false) {
    const int rbase = u.pm * BM + wr * 64 + fr;
    const int cw = wc * 32 + 8 * fq;
    float v[8];
    switch (g.epi) {
    case EK_IN: {
        const int pn = u.pn;
#pragma unroll
        for (int ai = 0; ai < 2; ++ai)
#pragma unroll
            for (int m = 0; m < 4; ++m) {
                const int r = rbase + ai * HALF + m * 16;
                if (pn < 2) {
#pragma unroll
                    for (int bj = 0; bj < 2; ++bj) { LOADV(v, ai, bj, m); const int col = pn * 256 + bj * HALF + cw, gq = col >> 4, c0 = col & 15;
                        *(v4u*)(E.U() + ((size_t)(gq * NCHUNK + (r >> 5)) * UPITCH + (r & 31) * 16 + c0)) = pack8(v); }
                } else if (pn == 2) {
                    float s = 0.f;
#pragma unroll
                    for (int bj = 0; bj < 2; ++bj) { LOADV(v, ai, bj, m);
#pragma unroll
                        for (int j = 0; j < 8; ++j) s += v[j] * v[j];
                        *(v4u*)(E.CQ() + (size_t)r * 384 + bj * HALF + cw) = pack8(v); }
                    s = quad_sum16(s); if (fq == 0 && !probe) fx_add(E.ssq_q() + r, s);
                } else if (pn == 3) {
                    LOADV(v, ai, 0, m); float s = 0.f;
#pragma unroll
                    for (int j = 0; j < 8; ++j) s += v[j] * v[j];
                    *(v4u*)(E.CQ() + (size_t)r * 384 + 256 + cw) = pack8(v);
                    s = quad_sum16(s); if (fq == 0 && !probe) fx_add(E.ssq_q() + r, s);
                    if (wc == 0) {
                        LOADV(v, ai, 1, m); rope8(v, E.tab() + (size_t)r * 16, fq);
                        const v4u w = pack8(v); const int b = r >> 12, t = r & 4095;
#pragma unroll
                        for (int h = 0; h < 8; ++h) *(v4u*)(E.Kb() + ((size_t)((b * 8 + h) * SEQ + t)) * 96 + 64 + 8 * fq) = w;
                    }
                } else if (pn == 4) {
                    float s = 0.f;
#pragma unroll
                    for (int bj = 0; bj < 2; ++bj) { LOADV(v, ai, bj, m);
#pragma unroll
                        for (int j = 0; j < 8; ++j) s += v[j] * v[j];
                        *(v4u*)(E.CKV() + (size_t)r * 256 + bj * HALF + cw) = pack8(v); }
                    s = quad_sum16(s); if (fq == 0 && !probe) fx_add(E.ssq_kv() + r, s);
                } else {
#pragma unroll
                    for (int bj = 0; bj < 2; ++bj) { LOADV(v, ai, bj, m); const int col = (pn - 5) * 256 + bj * HALF + cw;
                        const f32x4 b0 = *(const f32x4*)(E.b_gate + col), b1 = *(const f32x4*)(E.b_gate + col + 4);
                        v[0] = sigmoidf_(v[0] + b0[0]); v[1] = sigmoidf_(v[1] + b0[1]); v[2] = sigmoidf_(v[2] + b0[2]); v[3] = sigmoidf_(v[3] + b0[3]);
                        v[4] = sigmoidf_(v[4] + b1[0]); v[5] = sigmoidf_(v[5] + b1[1]); v[6] = sigmoidf_(v[6] + b1[2]); v[7] = sigmoidf_(v[7] + b1[3]);
                        unsigned q[8];
#pragma unroll
                        for (int j = 0; j < 8; ++j) q[j] = (unsigned)(v[j] * 255.0f + 0.5f);
                        *(v2u*)(E.GATES() + (size_t)r * 2048 + col) = (v2u){q[0] | (q[1] << 8) | (q[2] << 16) | (q[3] << 24), q[4] | (q[5] << 8) | (q[6] << 16) | (q[7] << 24)}; }
                }
            }
    } break;
    case EK_MEMKV: {
#pragma unroll
        for (int ai = 0; ai < 2; ++ai)
#pragma unroll
            for (int m = 0; m < 4; ++m) {
                const int r = rbase + ai * HALF + m * 16, b = r >> 8, key = r & 255;
#pragma unroll
                for (int bj = 0; bj < 2; ++bj) { LOADV(v, ai, bj, m); const int col = u.pn * 256 + bj * HALF + cw, c2 = col & 1023, h = c2 >> 8, d = c2 & 255;
                    *(v4u*)((col < 1024 ? E.KM() : E.VT()) + ((size_t)((h * 8 + b) * 256 + key)) * 256 + d) = pack8(v); }
            }
    } break;
    case EK_Q: {
        constexpr float QS = 0.10206207261596577f * 1.4426950408889634f;
#pragma unroll
        for (int ai = 0; ai < 2; ++ai)
#pragma unroll
            for (int m = 0; m < 4; ++m) {
                const int r = rbase + ai * HALF + m * 16, b = r >> 12, t = r & 4095;
                const float sc = rsqrtf(fx_get(E.ssq_q() + r) * (1.0f / 384.0f) + EPS) * QS;
#pragma unroll
                for (int bj = 0; bj < 2; ++bj) { LOADV(v, ai, bj, m);
#pragma unroll
                    for (int j = 0; j < 8; ++j) v[j] *= sc;
                    if (u.pn < 2) { const int col = u.pn * 256 + bj * HALF + cw, h = col >> 6, d = col & 63;
                        *(v4u*)(E.Qb() + ((size_t)((b * 8 + h) * SEQ + t)) * 96 + d) = pack8(v); }
                    else { const int h = 4 * bj + wc; rope8(v, E.tab() + (size_t)r * 16, fq);
                        *(v4u*)(E.Qb() + ((size_t)((b * 8 + h) * SEQ + t)) * 96 + 64 + 8 * fq) = pack8(v); }
                }
            }
    } break;
    case EK_KV: {
#pragma unroll
        for (int ai = 0; ai < 2; ++ai)
#pragma unroll
            for (int m = 0; m < 4; ++m) {
                const int r = rbase + ai * HALF + m * 16, b = r >> 12, t = r & 4095;
                const float sc = rsqrtf(fx_get(E.ssq_kv() + r) * (1.0f / 256.0f) + EPS);
#pragma unroll
                for (int bj = 0; bj < 2; ++bj) { LOADV(v, ai, bj, m);
#pragma unroll
                    for (int j = 0; j < 8; ++j) v[j] *= sc;
                    const int col = (u.pn & 1) * 256 + bj * HALF + cw, h = col >> 6, d = col & 63;
                    if (u.pn < 2) *(v4u*)(E.Kb() + ((size_t)((b * 8 + h) * SEQ + t)) * 96 + d) = pack8(v);
                    else *(v4u*)(E.Vb() + ((size_t)((b * 8 + h) * SEQ + t)) * 64 + d) = pack8(v);
                }
            }
    } break;
    case EK_Y: {
#pragma unroll
        for (int ai = 0; ai < 2; ++ai)
#pragma unroll
            for (int m = 0; m < 4; ++m) {
                const int r = rbase + ai * HALF + m * 16;
#pragma unroll
                for (int bj = 0; bj < 2; ++bj) { LOADV(v, ai, bj, m);
#pragma unroll
                    for (int j = 0; j < 8; ++j) v[j] = gelu_tanh(v[j]);
                    const int col = u.pn * 256 + bj * HALF + cw, t = col >> 4, c0 = col & 15;
                    *(v4u*)(E.YS() + ((size_t)(r * TCH + t)) * 512 + u.z * 16 + c0) = pack8(v); }
            }
    } break;
    case EK_P4: {
#pragma unroll
        for (int ai = 0; ai < 2; ++ai)
#pragma unroll
            for (int m = 0; m < 4; ++m) {
                const int r = rbase + ai * HALF + m * 16;
                if (u.z == 0) {
                    float a[8], gt[8]; LOADV(a, ai, 0, m); LOADV(gt, ai, 1, m);
                    const int col = u.pn * 128 + cw;
                    const v2u gw = *(const v2u*)(E.GATES() + (size_t)r * 2048 + col); constexpr float I255 = 1.0f / 255.0f;
                    const float gs[8] = {(float)(gw.x & 255u) * I255, (float)((gw.x >> 8) & 255u) * I255, (float)((gw.x >> 16) & 255u) * I255, (float)(gw.x >> 24) * I255,
                                         (float)(gw.y & 255u) * I255, (float)((gw.y >> 8) & 255u) * I255, (float)((gw.y >> 16) & 255u) * I255, (float)(gw.y >> 24) * I255};
#pragma unroll
                    for (int j = 0; j < 8; ++j) v[j] = a[j] * sigmoidf_(gt[j]) * gs[j];
                    *(v4u*)(E.MERGED() + (size_t)r * 1024 + col) = pack8(v);
                } else {
#pragma unroll
                    for (int bj = 0; bj < 2; ++bj) { LOADV(v, ai, bj, m); const int col = u.pn * 256 + bj * HALF + cw;
                        const v2u gw = *(const v2u*)(E.GATES() + (size_t)r * 2048 + 1024 + col); constexpr float I255 = 1.0f / 255.0f;
                        const v4u sw = *(const v4u*)(E.MERGED() + (size_t)r * 1024 + col);
                        v[0] = v[0] * ((float)(gw.x & 255u) * I255) + bf_lo(sw.x); v[1] = v[1] * ((float)((gw.x >> 8) & 255u) * I255) + bf_hi(sw.x);
                        v[2] = v[2] * ((float)((gw.x >> 16) & 255u) * I255) + bf_lo(sw.y); v[3] = v[3] * ((float)(gw.x >> 24) * I255) + bf_hi(sw.y);
                        v[4] = v[4] * ((float)(gw.y & 255u) * I255) + bf_lo(sw.z); v[5] = v[5] * ((float)((gw.y >> 8) & 255u) * I255) + bf_hi(sw.z);
                        v[6] = v[6] * ((float)((gw.y >> 16) & 255u) * I255) + bf_lo(sw.w); v[7] = v[7] * ((float)(gw.y >> 24) * I255) + bf_hi(sw.w);
                        *(v4u*)(E.MERGED() + (size_t)r * 1024 + col) = pack8(v); }
                }
            }
    } break;
    case EK_OUT: case EK_MO: {
        u64* ssq = (g.epi == EK_OUT) ? E.ssq1() : E.ssq2();
#pragma unroll
        for (int ai = 0; ai < 2; ++ai)
#pragma unroll
            for (int m = 0; m < 4; ++m) {
                const int r = rbase + ai * HALF + m * 16; float s = 0.f;
                float qs = 0.f; if (g.epi == EK_MO) qs = H8_SCALE * rsqrtf(fx_get(E.ssq1() + r) * (1.0f / 1024.0f) + EPS);
#pragma unroll
                for (int bj = 0; bj < 2; ++bj) { LOADV(v, ai, bj, m); const int col = u.pn * 256 + bj * HALF + cw;
                    if (g.epi == EK_OUT) { const f32x4 x0 = *(const f32x4*)(E.x + (size_t)r * 1024 + col), x1 = *(const f32x4*)(E.x + (size_t)r * 1024 + col + 4);
                        v[0] += x0[0]; v[1] += x0[1]; v[2] += x0[2]; v[3] += x0[3]; v[4] += x1[0]; v[5] += x1[1]; v[6] += x1[2]; v[7] += x1[3]; }
                    else { const v4u hw = *(const v4u*)(E.HB() + (size_t)r * 1024 + col);
                        v[0] += bf_lo(hw.x); v[1] += bf_hi(hw.x); v[2] += bf_lo(hw.y); v[3] += bf_hi(hw.y); v[4] += bf_lo(hw.z); v[5] += bf_hi(hw.z); v[6] += bf_lo(hw.w); v[7] += bf_hi(hw.w); }
#pragma unroll
                    for (int j = 0; j < 8; ++j) s += v[j] * v[j];
                    *(v4u*)((probe ? (bf16*)E.H() : E.HB()) + (size_t)r * 1024 + col) = pack8(v);
                    if (g.epi == EK_MO && !probe) {
                        unsigned w0 = 0u, w1 = 0u;
#pragma unroll
                        for (int j = 0; j < 4; ++j) { w0 = __builtin_amdgcn_cvt_pk_u8_f32(__builtin_amdgcn_fmed3f(__builtin_rintf(__builtin_fmaf(v[j], qs, 128.0f)), 1.0f, 255.0f), j, w0);
                                                      w1 = __builtin_amdgcn_cvt_pk_u8_f32(__builtin_amdgcn_fmed3f(__builtin_rintf(__builtin_fmaf(v[4 + j], qs, 128.0f)), 1.0f, 255.0f), j, w1); }
                        *(v2u*)(E.H8() + (size_t)r * 1024 + col) = (v2u){w0 ^ 0x80808080u, w1 ^ 0x80808080u}; } }
                s = quad_sum16(s); if (fq == 0 && !probe) fx_add(ssq + r, s);
            }
    } break;
    case EK_W1: case EK_W2: case EK_W3: {
#pragma unroll
        for (int ai = 0; ai < 2; ++ai)
#pragma unroll
            for (int m = 0; m < 4; ++m) {
                const int r = rbase + ai * HALF + m * 16;
#pragma unroll
                for (int bj = 0; bj < 2; ++bj) { LOADV(v, ai, bj, m); const int col = u.pn * 256 + bj * HALF + cw;
                    bf16* p;
                    if (g.epi == EK_W1) p = E.W1() + ((size_t)(u.z * 256 + r)) * 1024 + col;
                    else if (g.epi == EK_W2) p = E.W2() + ((size_t)((r >> 8) * 1024 + u.z * 256 + (r & 255))) * 1024 + col;
                    else p = E.W3() + ((size_t)(u.pn * 1024 + r)) * 1024 + u.z * 256 + (col & 255);
                    *(v4u*)p = pack8(v); }
            }
    } break;
    case EK_PS2: {
#pragma unroll
        for (int ai = 0; ai < 2; ++ai)
#pragma unroll
            for (int m = 0; m < 4; ++m) {
                const int r = rbase + ai * HALF + m * 16;
#pragma unroll
                for (int bj = 0; bj < 2; ++bj) { LOADV(v, ai, bj, m);
                    const v4u ow = {pkh2(v[0], v[1]), pkh2(v[2], v[3]), pkh2(v[4], v[5]), pkh2(v[6], v[7])};
                    *(v4u*)(E.SC() + (size_t)r * 2048 + u.pn * 256 + bj * HALF + cw) = ow; }
            }
    } break;
    default: break;
    }
}

__device__ __forceinline__ void epilogue_ms2(const EpiArgs& E, Acc& acc, const Unit& u, int wr, int wc, int fr, int fq, PG8_LAS float* xch) {
    const int rbase = u.pm * BM + wr * 64 + fr, cw = wc * 32 + 8 * fq;
#pragma unroll
    for (int ai = 0; ai < 2; ++ai)
#pragma unroll
        for (int m = 0; m < 4; ++m) {
            const int r = rbase + ai * HALF + m * 16;
            const float sc = rsqrtf(fx_get(E.ssq1() + r) * (1.0f / 1024.0f) + EPS) * (0.0625f * 1.4426950408889634f);
            float s = 0.f;
#pragma unroll
            for (int bj = 0; bj < 2; ++bj)
#pragma unroll
                for (int n = 0; n < 2; ++n) { f32x4 t = acc[ai][bj][m][n];
                    t[0] = __builtin_amdgcn_exp2f(fminf(t[0] * sc, 100.f)); t[1] = __builtin_amdgcn_exp2f(fminf(t[1] * sc, 100.f)); t[2] = __builtin_amdgcn_exp2f(fminf(t[2] * sc, 100.f)); t[3] = __builtin_amdgcn_exp2f(fminf(t[3] * sc, 100.f));
                    s += (t[0] + t[1]) + (t[2] + t[3]); acc[ai][bj][m][n] = t; }
            s = quad_sum16(s);
            if (fq == 0) xch[(ai * HALF + wr * 64 + m * 16 + fr) * 4 + wc] = s;
        }
    asm volatile("s_waitcnt lgkmcnt(0)" ::: "memory"); __builtin_amdgcn_s_barrier(); asm volatile("" ::: "memory");
    float v[8];
#pragma unroll
    for (int ai = 0; ai < 2; ++ai)
#pragma unroll
        for (int m = 0; m < 4; ++m) {
            const int r = rbase + ai * HALF + m * 16;
            const f32x4 ps = *(const PG8_LAS f32x4*)(xch + (ai * HALF + wr * 64 + m * 16 + fr) * 4);
            const float inv = __builtin_amdgcn_rcpf((ps[0] + ps[1]) + (ps[2] + ps[3]));
#pragma unroll
            for (int bj = 0; bj < 2; ++bj) { LOADV(v, ai, bj, m);
#pragma unroll
                for (int j = 0; j < 8; ++j) v[j] *= inv;
                *(v4u*)(E.PM() + (size_t)r * 1024 + u.pn * 256 + bj * HALF + cw) = pack8(v); }
        }
}

__device__ __forceinline__ void epilogue_sloc(const EpiArgs& E, const Acc& acc, const Unit& u, int wr, int wc, int fr, int fq) {
    const int rbase = u.pm * BM + wr * 64 + fr, cw = wc * 32 + 8 * fq, g = u.z;
    float v[8];
#pragma unroll
    for (int ai = 0; ai < 2; ++ai)
#pragma unroll
        for (int m = 0; m < 4; ++m) {
            const int r = rbase + ai * HALF + m * 16;
#pragma unroll
            for (int bj = 0; bj < 2; ++bj) { LOADV(v, ai, bj, m); float* p = E.SLOC() + ((size_t)(g * NCHUNK + r)) * 256 + bj * HALF + cw;
                *(f32x4*)p = (f32x4){v[0], v[1], v[2], v[3]}; *(f32x4*)(p + 4) = (f32x4){v[4], v[5], v[6], v[7]}; }
        }
    asm volatile("s_waitcnt vmcnt(0)" ::: "memory");
    __syncthreads();
    int tid = threadIdx.x; asm volatile("" : "+v"(tid));
    if (tid < 256) {
        const int bl = tid >> 7, dir = (tid >> 6) & 1, p = tid & 63;
        const int pi = (dir * 32 + g) * 64 + p;
        const float dt = __expf(E.log_dt[dir * 32 + g]);
        const float lr = E.lam_re[pi], li = E.lam_im[pi];
        const float mag = __expf((float)TCH * lr * dt); float sn, cs; sincos_rev((float)TCH * li * dt, sn, cs);
        const float Ar = mag * cs, Ai = mag * sn;
        const int row0 = u.pm * BM + bl * 128;
        const unsigned long long* S = (const unsigned long long*)(E.SLOC() + ((size_t)(g * NCHUNK + row0)) * 256 + dir * 128 + p * 2);
        bf16* C = E.U() + ((size_t)(g * NCHUNK + row0)) * UPITCH + 512 + dir * 128 + p * 2;
        float fr_ = 0.f, fi_ = 0.f;
        for (int n0 = 0; n0 < 128; n0 += 16) {
            unsigned long long sv[16];
#pragma unroll
            for (int k = 0; k < 16; ++k) { const int n = dir ? (127 - (n0 + k)) : (n0 + k); sv[k] = __hip_atomic_load(S + (size_t)n * 128, RLX_AGENT); }
#pragma unroll
            for (int k = 0; k < 16; ++k) { const int n = dir ? (127 - (n0 + k)) : (n0 + k);
                *(unsigned*)(C + (size_t)n * UPITCH) = pk2(fr_, fi_);
                const float sr = __builtin_bit_cast(float, (unsigned)sv[k]), si = __builtin_bit_cast(float, (unsigned)(sv[k] >> 32));
                const float nr = Ar * fr_ - Ai * fi_ + sr, ni = Ar * fi_ + Ai * fr_ + si; fr_ = nr; fi_ = ni; }
        }
    }
}

template <bool DUMMY = true>
__device__ __forceinline__ void gemm_phase(PG8_LAS unsigned char* lds, const GemmDesc& g, const EpiArgs& E, int G, int c, int mode = 0) {
    const bool dry = (mode == 1);
    int tid_ = threadIdx.x; asm volatile("" : "+v"(tid_));
    const int tid = tid_, wid = __builtin_amdgcn_readfirstlane(tid >> 6), lane = tid & 63, wr = wid >> 2, wc = wid & 3, fr = lane & 15, fq = lane >> 4;
    const int K = g.K, nt = K / BK, lda = g.lda, ldb = g.ldb;
    unsigned voffA[2], voffB[2];
#pragma unroll
    for (int i = 0; i < 2; ++i) { int R, C; stage_rc(tid * 16 + i * 8192, R, C); const int Rb = (R & ~31) + perm32(R & 31);
        voffA[i] = (unsigned)(R * lda + C) * 2u; voffB[i] = (unsigned)(Rb * ldb + C) * 2u; }
    const size_t kstep = (size_t)(BK * 2);
    const size_t hA = (size_t)HALF * lda * 2, hB = (size_t)HALF * ldb * 2;
    const unsigned ldsw = (unsigned)wid * 1024u;
    const int aoff = lds_byte(wr * 64 + fr, fq * 8), boff = lds_byte(wc * 32 + fr, fq * 8);
#define PG8_SA(b, h) (((b) * 2 + (h)) * HTB)
#define PG8_SB(b, h) ((4 + (b) * 2 + (h)) * HTB)
#define PG8_STAGE(bufoff, gbase, voff) do { _Pragma("unroll") for (int _i = 0; _i < 2; ++_i) \
        __builtin_amdgcn_global_load_lds((const unsigned*)((const char*)(gbase) + (voff)[_i]), (PG8_LAS unsigned*)(lds + (bufoff) + ldsw + _i * 8192), 16, 0, 0); } while (0)
#define PG8_LDA(dst, b, h) do { _Pragma("unroll") for (int m = 0; m < 4; ++m) _Pragma("unroll") for (int k = 0; k < 2; ++k) dst[m][k] = *(const PG8_LAS bf16x8*)(lds + PG8_SA(b, h) + aoff + m * 2048 + k * 1024); } while (0)
#define PG8_LDB(dst, b, h) do { _Pragma("unroll") for (int n = 0; n < 2; ++n) _Pragma("unroll") for (int k = 0; k < 2; ++k) dst[n][k] = *(const PG8_LAS bf16x8*)(lds + PG8_SB(b, h) + boff + n * 2048 + k * 1024); } while (0)
#define PG8_MMA(ai, bj, At, Bt) do { __builtin_amdgcn_s_setprio(1); _Pragma("unroll") for (int m = 0; m < 4; ++m) _Pragma("unroll") for (int n = 0; n < 2; ++n) _Pragma("unroll") for (int k = 0; k < 2; ++k) \
        acc[ai][bj][m][n] = __builtin_amdgcn_mfma_f32_16x16x32_bf16(Bt[n][k], At[m][k], acc[ai][bj][m][n], 0, 0, 0); __builtin_amdgcn_s_setprio(0); } while (0)
#define PG8_WAIT_V(n) asm volatile("s_waitcnt vmcnt(" #n ")" ::: "memory")
#define PG8_WAIT_L(n) asm volatile("s_waitcnt lgkmcnt(" #n ")" ::: "memory")
#define PG8_BAR __builtin_amdgcn_s_barrier()
#define PG8_SCHED __builtin_amdgcn_sched_barrier(0)
    Unit cur, nxt; int ui = 0;
    if (!g.next(0, G, c, cur)) return;
    Acc acc;
#pragma unroll
    for (int a = 0; a < 2; ++a)
#pragma unroll
        for (int b = 0; b < 2; ++b)
#pragma unroll
            for (int m = 0; m < 4; ++m)
#pragma unroll
                for (int n = 0; n < 2; ++n) acc[a][b][m][n] = (f32x4){0.f, 0.f, 0.f, 0.f};
    bf16x8 At[4][2], B0[2][2], B1[2][2];
    const char* cA = g.aptr(cur); const char* cB = g.bptr(cur);
    PG8_STAGE(PG8_SB(0, 0), cB, voffB); PG8_STAGE(PG8_SB(0, 1), cB + hB, voffB); PG8_STAGE(PG8_SA(0, 0), cA, voffA); PG8_STAGE(PG8_SA(0, 1), cA + hA, voffA);
    if (wr == 1) PG8_BAR;
    PG8_WAIT_V(2); PG8_BAR;
    PG8_STAGE(PG8_SB(1, 0), cB + kstep, voffB); PG8_STAGE(PG8_SA(1, 0), cA + kstep, voffA); PG8_STAGE(PG8_SB(1, 1), cB + hB + kstep, voffB);
    PG8_WAIT_V(6); PG8_BAR;
    for (;;) {
        const bool has_next = g.next(ui + 1, G, c, nxt);
        const char* nA = has_next ? g.aptr(nxt) : cA; const char* nB = has_next ? g.bptr(nxt) : cB;
        for (int t = 0; t < nt; t += 2) {
            const bool last = (t == nt - 2);
            const char* a1 = cA + (size_t)(t + 1) * kstep;
            const char* a2 = last ? nA : cA + (size_t)(t + 2) * kstep; const char* b2 = last ? nB : cB + (size_t)(t + 2) * kstep;
            const char* a3 = a2 + kstep; const char* b3 = b2 + kstep;
            PG8_LDB(B0, 0, 0); PG8_LDB(B1, 0, 1); PG8_SCHED; PG8_LDA(At, 0, 0); PG8_STAGE(PG8_SA(1, 1), a1 + hA, voffA);
            PG8_WAIT_V(8); PG8_WAIT_L(0); PG8_BAR; PG8_MMA(0, 0, At, B0); PG8_MMA(0, 1, At, B1); PG8_BAR; PG8_SCHED;
            PG8_LDA(At, 0, 1); PG8_STAGE(PG8_SB(0, 0), b2, voffB); PG8_STAGE(PG8_SB(0, 1), b2 + hB, voffB); PG8_STAGE(PG8_SA(0, 0), a2, voffA);
            PG8_WAIT_V(8); PG8_WAIT_L(0); PG8_BAR; PG8_MMA(1, 0, At, B0); PG8_MMA(1, 1, At, B1); PG8_BAR; PG8_SCHED;
            PG8_LDB(B0, 1, 0); PG8_LDB(B1, 1, 1); PG8_SCHED; PG8_LDA(At, 1, 0); PG8_STAGE(PG8_SA(0, 1), a2 + hA, voffA);
            PG8_WAIT_V(8); PG8_WAIT_L(0); PG8_BAR; PG8_MMA(0, 0, At, B0); PG8_MMA(0, 1, At, B1); PG8_BAR; PG8_SCHED;
            PG8_LDA(At, 1, 1); PG8_STAGE(PG8_SB(1, 0), b3, voffB); PG8_STAGE(PG8_SB(1, 1), b3 + hB, voffB); PG8_STAGE(PG8_SA(1, 0), a3, voffA);
            PG8_WAIT_V(8); PG8_WAIT_L(0); PG8_BAR; PG8_MMA(1, 0, At, B0); PG8_MMA(1, 1, At, B1); PG8_BAR; PG8_SCHED;
        }
        if (wr == 0) PG8_BAR;
        if (!g.after_drain && !dry) { if (g.epi == EK_MS2) epilogue_ms2(E, acc, cur, wr, wc, fr, fq, (PG8_LAS float*)(lds + XCH_OFF_) + (ui & 1) * 1024); else epilogue(g, E, acc, cur, wr, wc, fr, fq, mode == 2); }
        if (dry) { _Pragma("unroll") for (int a = 0; a < 2; ++a) _Pragma("unroll") for (int b = 0; b < 2; ++b) _Pragma("unroll") for (int m = 0; m < 4; ++m) _Pragma("unroll") for (int n = 0; n < 2; ++n) asm volatile("" :: "v"(acc[a][b][m][n])); }
        if (!has_next) break;
#pragma unroll
        for (int a = 0; a < 2; ++a)
#pragma unroll
            for (int b = 0; b < 2; ++b)
#pragma unroll
                for (int m = 0; m < 4; ++m)
#pragma unroll
                    for (int n = 0; n < 2; ++n) acc[a][b][m][n] = (f32x4){0.f, 0.f, 0.f, 0.f};
        cur = nxt; cA = nA; cB = nB; ++ui;
        if (wr == 1) PG8_BAR;
    }
    PG8_WAIT_V(0);
    PG8_BAR;
    if (g.after_drain && !dry) epilogue_sloc(E, acc, cur, wr, wc, fr, fq);
#undef PG8_SA
#undef PG8_SB
#undef PG8_STAGE
#undef PG8_LDA
#undef PG8_LDB
#undef PG8_MMA
#undef PG8_WAIT_V
#undef PG8_WAIT_L
#undef PG8_BAR
#undef PG8_SCHED
}
}

namespace att {
using s16x4  = __attribute__((ext_vector_type(4))) short;
using f32x16 = __attribute__((ext_vector_type(16))) float;
constexpr int DQK = 96, DV = 64, NW = 8, QBLK = 32, KVBLK = 64;
constexpr int KPITCH = DQK * 2 + 16;
constexpr int SHM_K = KVBLK * KPITCH, SHM_V = KVBLK * DV * 2;
constexpr int NBUF = 3;
constexpr int OFF_V = 0, OFF_K = NBUF * SHM_V, OFF_WS = OFF_K + NBUF * SHM_K;
constexpr float THRL = 8.0f;
#define SBAR() __builtin_amdgcn_sched_barrier(0)
__device__ __forceinline__ int crow(int r, int hi) { return (r & 3) + 8 * (r >> 2) + 4 * hi; }
__device__ __forceinline__ unsigned cvtpk(float lo, float hi) { unsigned r; asm volatile("v_cvt_pk_bf16_f32 %0, %1, %2" : "=v"(r) : "v"(lo), "v"(hi)); return r; }
__device__ __forceinline__ float max3f(float a, float b, float c) { return __builtin_fmaxf(__builtin_fmaxf(a, b), c); }
template <bool FIRST>
__device__ __forceinline__ void partialSM(f32x16& p0, f32x16& p1, float& m_reg, f32x16& negm, float& alpha) {
    float a = max3f(p0[0], p0[1], p1[0]), b = max3f(p0[2], p0[3], p1[1]); a = max3f(a, p1[2], p1[3]);
#pragma unroll
    for (int r = 4; r < 16; r += 4) { a = max3f(a, p0[r], p0[r + 1]); b = max3f(b, p0[r + 2], p0[r + 3]); a = max3f(a, p1[r], p1[r + 1]); b = max3f(b, p1[r + 2], p1[r + 3]); }
    float pmax = fmaxf(a, b);
    { auto rr = __builtin_amdgcn_permlane32_swap(__float_as_uint(pmax), __float_as_uint(pmax), false, false);
      pmax = fmaxf(__uint_as_float(rr[0]), __uint_as_float(rr[1])); }
    alpha = 1.f;
    if (FIRST || !__builtin_expect(__all(pmax <= THRL), 1)) {
        const float d = FIRST ? pmax : fmaxf(pmax, 0.f);
        m_reg += d; if (!FIRST) alpha = __builtin_amdgcn_exp2f(-d);
#pragma unroll
        for (int r = 0; r < 16; ++r) { p0[r] -= d; p1[r] -= d; }
#pragma unroll
        for (int r = 0; r < 16; ++r) negm[r] = -m_reg;
    }
#pragma unroll
    for (int r = 0; r < 16; ++r) p0[r] = __builtin_amdgcn_exp2f(p0[r]);
}
__device__ __forceinline__ void finishSM(f32x16& p0, f32x16& p1, float alpha, float& l_reg, bf16x8& pa0, bf16x8& pa1, bf16x8& pa2, bf16x8& pa3) {
#pragma unroll
    for (int r = 0; r < 16; ++r) p1[r] = __builtin_amdgcn_exp2f(p1[r]);
    float ps = 0;
#pragma unroll
    for (int r = 0; r < 16; ++r) ps += p0[r];
#pragma unroll
    for (int r = 0; r < 16; ++r) ps += p1[r];
    { auto rr = __builtin_amdgcn_permlane32_swap(__float_as_uint(ps), __float_as_uint(ps), false, false);
      ps = __uint_as_float(rr[0]) + __uint_as_float(rr[1]); }
    l_reg = l_reg * alpha + ps;
#define PK4(P, BASE, OUT) do { unsigned a0 = cvtpk(P[BASE + 0], P[BASE + 1]), a1 = cvtpk(P[BASE + 2], P[BASE + 3]);   \
    unsigned b0 = cvtpk(P[BASE + 4], P[BASE + 5]), b1 = cvtpk(P[BASE + 6], P[BASE + 7]);                              \
    auto r0 = __builtin_amdgcn_permlane32_swap(a0, b0, false, false); auto r1 = __builtin_amdgcn_permlane32_swap(a1, b1, false, false); \
    v4u w = {r0[0], r1[0], r0[1], r1[1]}; OUT = *reinterpret_cast<bf16x8*>(&w); } while (0)
    PK4(p0, 0, pa0); PK4(p0, 8, pa1); PK4(p1, 0, pa2); PK4(p1, 8, pa3);
#undef PK4
}
__device__ __forceinline__ void qkt(f32x16& p0, f32x16& p1, const char* Ks, const bf16x8* qr, const f32x16& negm, int r32, int hi) {
#pragma unroll
    for (int d0 = 0; d0 < DQK / 16; ++d0) { const int cb = (d0 * 16 + hi * 8) * 2;
        const bf16x8 b0 = *reinterpret_cast<const bf16x8*>(Ks + r32 * KPITCH + cb);
        const bf16x8 b1 = *reinterpret_cast<const bf16x8*>(Ks + (32 + r32) * KPITCH + cb);
        if (d0 == 0) { p0 = __builtin_amdgcn_mfma_f32_32x32x16_bf16(b0, qr[0], negm, 0, 0, 0); p1 = __builtin_amdgcn_mfma_f32_32x32x16_bf16(b1, qr[0], negm, 0, 0, 0); }
        else { p0 = __builtin_amdgcn_mfma_f32_32x32x16_bf16(b0, qr[d0], p0, 0, 0, 0); p1 = __builtin_amdgcn_mfma_f32_32x32x16_bf16(b1, qr[d0], p1, 0, 0, 0); } }
}
__device__ __forceinline__ int v_st(int k, int c) { const int kk = (k & ~0xC) | ((k & 4) << 1) | ((k & 8) >> 1); return ((kk >> 3) * 2 + (c >> 5)) * 512 + ((kk & 7) * 32 + (c & 31)) * 2; }
__device__ __forceinline__ int v_rd_base(int lane) { return ((lane & 3) << 3) | (((lane >> 2) & 3) << 6) | (((lane >> 4) & 1) << 5) | (((lane >> 5) & 1) << 8); }
constexpr int v_rd_off(int d0, int ks, int half) { return d0 * 512 + ks * 2048 + half * 1024; }
template <int OFF> __device__ __forceinline__ s16x4 tr_read(int vb) {
    s16x4 r; asm volatile("ds_read_b64_tr_b16 %0, %1 offset:%2" : "=&v"(r) : "v"(vb), "i"(OFF) : "memory"); return r;
}
template <int D0> __device__ __forceinline__ void pv_one(f32x16& od, int vb, bf16x8 pa0, bf16x8 pa1, bf16x8 pa2, bf16x8 pa3) {
    const s16x4 l0 = tr_read<v_rd_off(D0, 0, 0)>(vb), h0 = tr_read<v_rd_off(D0, 0, 1)>(vb), l1 = tr_read<v_rd_off(D0, 1, 0)>(vb), h1 = tr_read<v_rd_off(D0, 1, 1)>(vb);
    const s16x4 l2 = tr_read<v_rd_off(D0, 2, 0)>(vb), h2 = tr_read<v_rd_off(D0, 2, 1)>(vb), l3 = tr_read<v_rd_off(D0, 3, 0)>(vb), h3 = tr_read<v_rd_off(D0, 3, 1)>(vb);
    asm volatile("s_waitcnt lgkmcnt(0)" ::: "memory"); SBAR();
#define PK(L, H) (bf16x8){L[0], L[1], L[2], L[3], H[0], H[1], H[2], H[3]}
    od = __builtin_amdgcn_mfma_f32_32x32x16_bf16(pa0, PK(l0, h0), od, 0, 0, 0);
    od = __builtin_amdgcn_mfma_f32_32x32x16_bf16(pa1, PK(l1, h1), od, 0, 0, 0);
    od = __builtin_amdgcn_mfma_f32_32x32x16_bf16(pa2, PK(l2, h2), od, 0, 0, 0);
    od = __builtin_amdgcn_mfma_f32_32x32x16_bf16(pa3, PK(l3, h3), od, 0, 0, 0);
#undef PK
}
__device__ __forceinline__ void pv_d0(f32x16* o, int vb, bf16x8 pa0, bf16x8 pa1, bf16x8 pa2, bf16x8 pa3) {
    pv_one<0>(o[0], vb, pa0, pa1, pa2, pa3); pv_one<1>(o[1], vb, pa0, pa1, pa2, pa3);
}
__device__ __forceinline__ void attn_unit(const bf16* __restrict__ Qb, const bf16* __restrict__ Kh, const bf16* __restrict__ Vh, bf16* __restrict__ Ob, char* lds) {
    int tid_ = threadIdx.x; asm volatile("" : "+v"(tid_));
    const int tid = tid_, wid = tid >> 6, lane = tid & 63, r32 = lane & 31, hi = lane >> 5;
    char* V_lds = lds + OFF_V; char* K_lds = lds + OFF_K;
    float* ws = (float*)(lds + OFF_WS) + wid * 64; float* li_l = ws; float* al_l = ws + 32;
    float m_reg = 0.f, l_reg = 0; f32x16 o[2] = {}; bf16x8 qr[DQK / 16]; f32x16 negm = {};
    const bf16* Qw = Qb + (long)(wid * QBLK + r32) * DQK + hi * 8;
#pragma unroll
    for (int d0 = 0; d0 < DQK / 16; ++d0) qr[d0] = *reinterpret_cast<const bf16x8*>(Qw + d0 * 16);
    const int kc0 = tid, kc1 = 512 + (tid & 255);
    const int kd0 = (kc0 / 12) * KPITCH + (kc0 % 12) * 16, kd1 = (kc1 / 12) * KPITCH + (kc1 % 12) * 16;
    const int vd0 = v_st(tid >> 3, (tid & 7) * 8);
    const int vb0 = (int)(uintptr_t)V_lds + v_rd_base(lane);
    const bool k1w = (__builtin_amdgcn_readfirstlane(tid) < 256);
    struct { bf16x8 vs0, ks0, ks1; } sr_[2];
#define SLOAD(i, k0) do { const char* kb_ = (const char*)(Kh + (long)(k0) * DQK); const char* vb_ = (const char*)(Vh + (long)(k0) * DV); \
    sr_[i].vs0 = *reinterpret_cast<const bf16x8*>(vb_ + tid * 16); sr_[i].ks0 = *reinterpret_cast<const bf16x8*>(kb_ + kc0 * 16); sr_[i].ks1 = *reinterpret_cast<const bf16x8*>(kb_ + kc1 * 16); } while (0)
#define SWRITE(slot, i) do { *(bf16x8*)(V_lds + (slot) * SHM_V + vd0) = sr_[i].vs0; *(bf16x8*)(K_lds + (slot) * SHM_K + kd0) = sr_[i].ks0; \
    if (k1w) *(bf16x8*)(K_lds + (slot) * SHM_K + kd1) = sr_[i].ks1; } while (0)
#define RESC(a) do { if (__any((a) < 1.f)) { if (hi == 0) al_l[r32] = (a); asm volatile("s_waitcnt lgkmcnt(0)" ::: "memory"); \
    _Pragma("unroll") for (int d = 0; d < 2; ++d) _Pragma("unroll") for (int r = 0; r < 16; ++r) o[d][r] *= al_l[crow(r, hi)]; } } while (0)
#define NEXT3(s) ((s) == 2 ? 0 : (s) + 1)
    f32x16 pA0, pA1, pB0, pB1; float alA, alB; bf16x8 pa0, pa1, pa2, pa3; constexpr int NT = SEQ / KVBLK;
    SLOAD(0, 0); asm volatile("s_waitcnt vmcnt(0)" ::: "memory"); SWRITE(0, 0);
    SLOAD(1, KVBLK); SLOAD(0, 2 * KVBLK);
    __syncthreads();
    qkt(pA0, pA1, K_lds, qr, negm, r32, hi); partialSM<true>(pA0, pA1, m_reg, negm, alA);
    SWRITE(1, 1);
    __syncthreads();
    int sk = 1, sv = 0;
    for (int j = 1; j + 1 < NT; j += 2) {
        SBAR(); qkt(pB0, pB1, K_lds + sk * SHM_K, qr, negm, r32, hi);
        finishSM(pA0, pA1, alA, l_reg, pa0, pa1, pa2, pa3); SBAR();
        SLOAD(1, (j + 2) * KVBLK); SBAR();
        pv_d0(o, vb0 + sv * SHM_V, pa0, pa1, pa2, pa3); partialSM<false>(pB0, pB1, m_reg, negm, alB);
        { const int sw = NEXT3(sk); SWRITE(sw, 0); }
        RESC(alB); __syncthreads();
        sv = sk; sk = NEXT3(sk);
        SBAR(); qkt(pA0, pA1, K_lds + sk * SHM_K, qr, negm, r32, hi);
        finishSM(pB0, pB1, alB, l_reg, pa0, pa1, pa2, pa3); SBAR();
        SLOAD(0, (j + 3 < NT ? j + 3 : NT - 1) * KVBLK); SBAR();
        pv_d0(o, vb0 + sv * SHM_V, pa0, pa1, pa2, pa3); partialSM<false>(pA0, pA1, m_reg, negm, alA);
        { const int sw = NEXT3(sk); SWRITE(sw, 1); }
        RESC(alA); __syncthreads();
        sv = sk; sk = NEXT3(sk);
    }
    SBAR(); qkt(pB0, pB1, K_lds + sk * SHM_K, qr, negm, r32, hi);
    finishSM(pA0, pA1, alA, l_reg, pa0, pa1, pa2, pa3); SBAR();
    pv_d0(o, vb0 + sv * SHM_V, pa0, pa1, pa2, pa3); partialSM<false>(pB0, pB1, m_reg, negm, alB);
    RESC(alB);
    finishSM(pB0, pB1, alB, l_reg, pa0, pa1, pa2, pa3); SBAR();
    pv_d0(o, vb0 + sk * SHM_V, pa0, pa1, pa2, pa3);
    if (hi == 0) li_l[r32] = l_reg; asm volatile("s_waitcnt lgkmcnt(0)" ::: "memory");
    float rli[16];
#pragma unroll
    for (int r = 0; r < 16; ++r) rli[r] = __builtin_amdgcn_rcpf(li_l[crow(r, hi)]);
    bf16* Ow = Ob + (long)(wid * QBLK) * 512;
#pragma unroll
    for (int r = 0; r < 16; ++r) { const int orow = crow(r, hi);
#pragma unroll
        for (int d0 = 0; d0 < 2; ++d0) Ow[(long)orow * 512 + d0 * 32 + r32] = (bf16)f2bf(o[d0][r] * rli[r]); }
    __syncthreads();
#undef SLOAD
#undef SWRITE
#undef RESC
#undef NEXT3
}
#undef SBAR
}

struct Args { const void* in[32]; float* out; unsigned char* ws; };

__device__ __forceinline__ int dst_row(int code, int n) {
    switch (code) {
    case 1: return n < 896 ? n : (n < 1152 ? 1024 + n - 896 : (n < 1184 ? 896 + n - 1152 : 1280 + n - 1184));
    case 2: { const int sel = n >> 10, j = n & 1023; return 256 * (j >> 7) + 128 * sel + (j & 127); }
    case 3: { const int h = n / 96, e = n % 96; return e < 64 ? h * 64 + e : 512 + h * 32 + e - 64; }
    case 4: { const int h = n >> 7, e = n & 127; return e < 64 ? h * 64 + e : 512 + h * 64 + e - 64; }
    default: return n;
    }
}
__device__ __forceinline__ void transpose_item(const float* W, int K, int N, bf16* WT, int code, const float* gs, LAS float* scr, int item, int lane) {
    const int nblk = N / 32, kb = item / nblk, nb = item % nblk, k0 = 64 * kb, n0 = 32 * nb;
#pragma unroll 16
    for (int i = 0; i < 32; ++i) { const int kk = 2 * i + (lane >> 5); float w = W[(size_t)(k0 + kk) * N + n0 + (lane & 31)]; if (gs) w *= gs[k0 + kk]; scr[kk * 33 + (lane & 31)] = w; }
    LDS_WAIT(); asm volatile("" ::: "memory");
    const int c = lane & 7; const int r0 = dst_row(code, n0);
#pragma unroll
    for (int j = 0; j < 4; ++j) { const int n = (lane >> 3) + 8 * j; const LAS float* s = scr + (8 * c) * 33 + n;
        v4u o; o.x = pk2(s[0 * 33], s[1 * 33]); o.y = pk2(s[2 * 33], s[3 * 33]); o.z = pk2(s[4 * 33], s[5 * 33]); o.w = pk2(s[6 * 33], s[7 * 33]);
        *(GAS v4u*)(WT + (size_t)(r0 + n) * K + k0 + 8 * c) = o; }
    LDS_WAIT(); asm volatile("" ::: "memory");
}
__device__ __forceinline__ void rms_rows2_to_bf16(const float* xrow0, const float* xrow1, const float* gain, bf16* orow0, bf16* orow1, int lane) {
    const f32x4* xa = (const f32x4*)xrow0 + lane; const f32x4* xb = (const f32x4*)xrow1 + lane; const f32x4* gr = (const f32x4*)gain + lane;
    f32x4 v[4], w[4]; float s = 0.f, t = 0.f;
#pragma unroll
    for (int j = 0; j < 4; ++j) { v[j] = xa[64 * j]; w[j] = xb[64 * j]; }
#pragma unroll
    for (int j = 0; j < 4; ++j) { s += (v[j].x * v[j].x + v[j].y * v[j].y) + (v[j].z * v[j].z + v[j].w * v[j].w); t += (w[j].x * w[j].x + w[j].y * w[j].y) + (w[j].z * w[j].z + w[j].w * w[j].w); }
#pragma unroll
    for (int o = 1; o < 64; o <<= 1) { s += __shfl_xor(s, o); t += __shfl_xor(t, o); }
    const float ra = rsqrtf(s * (1.f / 1024.f) + EPS), rb = rsqrtf(t * (1.f / 1024.f) + EPS);
    unsigned long long* oa = (unsigned long long*)orow0 + lane; unsigned long long* ob = (unsigned long long*)orow1 + lane;
#pragma unroll
    for (int j = 0; j < 4; ++j) { const f32x4 gg = gr[64 * j];
        oa[64 * j] = (unsigned long long)pk2(v[j].x * ra * gg.x, v[j].y * ra * gg.y) | ((unsigned long long)pk2(v[j].z * ra * gg.z, v[j].w * ra * gg.w) << 32);
        ob[64 * j] = (unsigned long long)pk2(w[j].x * rb * gg.x, w[j].y * rb * gg.y) | ((unsigned long long)pk2(w[j].z * rb * gg.z, w[j].w * rb * gg.w) << 32); }
}
__device__ __forceinline__ void rms_row_to_f32(const float* xrow, const float* gain, float* orow, int lane) {
    const f32x4* xr = (const f32x4*)xrow + lane; const f32x4* gr = (const f32x4*)gain + lane;
    f32x4 v[4]; float s = 0.f;
#pragma unroll
    for (int j = 0; j < 4; ++j) { v[j] = xr[64 * j]; s += (v[j].x * v[j].x + v[j].y * v[j].y) + (v[j].z * v[j].z + v[j].w * v[j].w); }
    const float rstd = rsqrtf(wave_sum(s) * (1.f / 1024.f) + EPS);
    f32x4* o = (f32x4*)orow + lane;
#pragma unroll
    for (int j = 0; j < 4; ++j) { const f32x4 gg = gr[64 * j]; o[64 * j] = (f32x4){v[j].x * rstd * gg.x, v[j].y * rstd * gg.y, v[j].z * rstd * gg.z, v[j].w * rstd * gg.w}; }
}

struct SsmP { const float *lam_re, *lam_im, *log_dt, *b_re, *b_im, *c_re, *c_im, *dsk; };
__device__ __forceinline__ void ssm_pow(const SsmP& P, int dir, int g, int p, float e, float& pr, float& pi_) {
    const int ix = (dir * 32 + g) * 64 + p; const float dt = __expf(P.log_dt[dir * 32 + g]);
    const float mag = __expf(e * P.lam_re[ix] * dt); float sn, cs; sincos_rev(e * P.lam_im[ix] * dt, sn, cs); pr = mag * cs; pi_ = mag * sn;
}
__device__ __forceinline__ void ssm_fbar(const SsmP& P, int dir, int g, int p, float& fr, float& fi) {
    const int ix = (dir * 32 + g) * 64 + p; float ar, ai; ssm_pow(P, dir, g, p, 1.0f, ar, ai);
    const float lr = P.lam_re[ix], li = P.lam_im[ix], nr = ar - 1.0f, den = lr * lr + li * li;
    fr = (nr * lr + ai * li) / den; fi = (ai * lr - nr * li) / den;
}
__device__ __forceinline__ void ssm_lag_item(const SsmP& P, bf16* MF, int g, int j, LAS float* scr, int lane) {
    float acc4[4] = {0.f, 0.f, 0.f, 0.f};
    const int c = lane >> 2, cp0 = (lane & 3) * 4;
    for (int dir = 0; dir < 2; ++dir) {
        if ((dir == 0 && j < 0) || (dir == 1 && j > 0)) continue;
        const int p = lane; float pr, pi_, fr, fi; ssm_pow(P, dir, g, p, (float)(j < 0 ? -j : j), pr, pi_); ssm_fbar(P, dir, g, p, fr, fi);
        const float wr_ = pr * fr - pi_ * fi, wi_ = pr * fi + pi_ * fr;
        const float* br = P.b_re + ((size_t)((dir * 32 + g) * 64 + p)) * 16; const float* bi = P.b_im + ((size_t)((dir * 32 + g) * 64 + p)) * 16;
#pragma unroll
        for (int q = 0; q < 16; ++q) { const float zr = wr_ * br[q] - wi_ * bi[q], zi = wr_ * bi[q] + wi_ * br[q]; scr[(p * 16 + q) * 2] = zr; scr[(p * 16 + q) * 2 + 1] = zi; }
        LDS_WAIT(); asm volatile("" ::: "memory");
        const float* cr = P.c_re + ((size_t)((dir * 32 + g) * 16 + c)) * 64; const float* ci = P.c_im + ((size_t)((dir * 32 + g) * 16 + c)) * 64;
        for (int pp = 0; pp < 64; ++pp) { const float a = cr[pp], b = ci[pp];
#pragma unroll
            for (int q = 0; q < 4; ++q) acc4[q] += a * scr[(pp * 16 + cp0 + q) * 2] - b * scr[(pp * 16 + cp0 + q) * 2 + 1]; }
        LDS_WAIT(); asm volatile("" ::: "memory");
    }
    if (j == 0) {
#pragma unroll
        for (int q = 0; q < 4; ++q) if (cp0 + q == c) acc4[q] += P.dsk[g * 16 + c];
    }
    const v2u w = {pk2(acc4[0], acc4[1]), pk2(acc4[2], acc4[3])};
    const int tlo = j > 0 ? j : 0, thi = j < 0 ? 31 + j : 31;
    for (int t = tlo; t <= thi; ++t) *(v2u*)(MF + ((size_t)(g * 512 + t * 16 + c)) * UPITCH + (t - j) * 16 + cp0) = w;
}
__device__ __forceinline__ void ssm_out_item(const SsmP& P, bf16* MF, int g, int t, int lane) {
    const int p = lane;
    for (int dir = 0; dir < 2; ++dir) {
        float pr, pi_; ssm_pow(P, dir, g, p, dir == 0 ? (float)(t + 1) : (float)(TCH - t), pr, pi_);
        for (int c = 0; c < 16; ++c) { const size_t ci = ((size_t)((dir * 32 + g) * 16 + c)) * 64 + p; const float cr = P.c_re[ci], cim = P.c_im[ci];
            const float zr = cr * pr - cim * pi_, zi = cr * pi_ + cim * pr;
            *(unsigned*)(MF + ((size_t)(g * 512 + t * 16 + c)) * UPITCH + 512 + dir * 128 + p * 2) = pk2(zr, -zi); }
    }
}
__device__ __forceinline__ void ssm_st_item(const SsmP& P, bf16* WST, int g, int dir, int p, int lane) {
    const int tp = lane >> 1, c0 = (lane & 1) * 8;
    float pr, pi_, fr, fi; ssm_pow(P, dir, g, p, dir == 0 ? (float)(TCH - 1 - tp) : (float)tp, pr, pi_); ssm_fbar(P, dir, g, p, fr, fi);
    const float wr_ = pr * fr - pi_ * fi, wi_ = pr * fi + pi_ * fr;
    const float* br = P.b_re + ((size_t)((dir * 32 + g) * 64 + p)) * 16 + c0; const float* bi = P.b_im + ((size_t)((dir * 32 + g) * 64 + p)) * 16 + c0;
    float zr[8], zi[8];
#pragma unroll
    for (int q = 0; q < 8; ++q) { zr[q] = wr_ * br[q] - wi_ * bi[q]; zi[q] = wr_ * bi[q] + wi_ * br[q]; }
    bf16* row = WST + ((size_t)(g * 256 + dir * 128 + p * 2)) * 512 + tp * 16 + c0;
    *(v4u*)row = pg8::pack8(zr); *(v4u*)(row + 512) = pg8::pack8(zi);
}

#define INS16(t, x) do { float x_ = (x); _Pragma("unroll") for (int i_ = 0; i_ < 16; ++i_) { const float a_ = fmaxf(t[i_], x_); x_ = fminf(t[i_], x_); t[i_] = a_; } } while (0)
#define CE_DESC(x, y) do { const float hi_ = fmaxf(x, y), lo_ = fminf(x, y); x = hi_; y = lo_; } while (0)
__device__ __forceinline__ void sort16_desc(float (&a)[16]) {
#pragma unroll
    for (int k = 2; k <= 16; k <<= 1)
#pragma unroll
        for (int j = k >> 1; j > 0; j >>= 1)
#pragma unroll
            for (int i = 0; i < 16; ++i) { const int l = i ^ j; if (l > i) { if ((i & k) == 0) CE_DESC(a[i], a[l]); else CE_DESC(a[l], a[i]); } }
}
__device__ __forceinline__ void merge16_desc(float (&t)[16], const float (&a)[16]) {
#pragma unroll
    for (int i = 0; i < 16; ++i) t[i] = fmaxf(t[i], a[15 - i]);
#pragma unroll
    for (int j = 8; j > 0; j >>= 1)
#pragma unroll
        for (int i = 0; i < 16; ++i) { const int l = i ^ j; if (l > i) CE_DESC(t[i], t[l]); }
}
__device__ __forceinline__ float packf(float v, unsigned code, unsigned mask) { return __builtin_bit_cast(float, (__builtin_bit_cast(unsigned, v) & ~mask) | code); }
__device__ __forceinline__ unsigned fp8x4(float a, float b, float c, float d) { int t = __builtin_amdgcn_cvt_pk_fp8_f32(a, b, 0, false); t = __builtin_amdgcn_cvt_pk_fp8_f32(c, d, t, true); return (unsigned)t; }
#define DEC8(w, lo, hi) do { lo = __builtin_amdgcn_cvt_pk_f32_fp8((int)(w), false); hi = __builtin_amdgcn_cvt_pk_f32_fp8((int)(w), true); } while (0)

__device__ __forceinline__ void peer_topk(unsigned char* ws, LAS unsigned char* ldsw, int gw, int NGW, int lane_) {
    int lane = lane_; asm volatile("" : "+v"(lane));
    const _Float16* SC = (const _Float16*)(ws + WS_SC);
    unsigned* SELI = (unsigned*)(ws + WS_SELI); float* SELW = (float*)(ws + WS_SELG);
    LAS unsigned* idxb = (LAS unsigned*)ldsw;
    v4u pf[16];
    if (gw < NTOK / 4) { const v4u* gp = (const v4u*)(SC + (size_t)gw * 4 * 2048) + lane;
#pragma unroll
        for (int b = 0; b < 16; ++b) pf[b] = gp[b * 64]; }
    for (int grp = gw; grp < NTOK / 4; grp += NGW) {
        const int tok0 = grp * 4;
#pragma unroll
        for (int b = 0; b < 16; ++b) { const int list = b * 4 + (lane >> 4), c = lane & 15; *(LAS v4u*)(ldsw + list * 256 + ((c ^ (list & 15)) << 4)) = pf[b]; }
        LDS_WAIT(); asm volatile("" ::: "memory");
        if (grp + NGW < NTOK / 4) { const v4u* gp = (const v4u*)(SC + (size_t)(grp + NGW) * 4 * 2048) + lane;
#pragma unroll
            for (int b = 0; b < 16; ++b) pf[b] = gp[b * 64]; }
        float t[16];
#pragma unroll
        for (int g = 0; g < 8; ++g) {
            float a[16];
#pragma unroll
            for (int hf = 0; hf < 2; ++hf) { const int i = g * 2 + hf; const v4u w = *(const LAS v4u*)(ldsw + lane * 256 + ((i ^ (lane & 15)) << 4));
                const unsigned ww[4] = {w.x, w.y, w.z, w.w};
#pragma unroll
                for (int q = 0; q < 4; ++q) { const h2_t h2 = __builtin_bit_cast(h2_t, ww[q]); const unsigned k = (unsigned)(i * 8 + q * 2);
                    a[hf * 8 + q * 2] = packf((float)h2.x, k, 127u); a[hf * 8 + q * 2 + 1] = packf((float)h2.y, k + 1, 127u); } }
            sort16_desc(a);
            if (g == 0) {
#pragma unroll
                for (int i = 0; i < 16; ++i) t[i] = a[i];
            } else merge16_desc(t, a);
        }
        LDS_WAIT(); asm volatile("" ::: "memory");
        { unsigned w0 = 0, w1 = 0, w2 = 0, w3 = 0;
#pragma unroll
          for (int i = 0; i < 4; ++i) { w0 |= (__builtin_bit_cast(unsigned, t[i]) & 127u) << (8 * i); w1 |= (__builtin_bit_cast(unsigned, t[4 + i]) & 127u) << (8 * i);
                                        w2 |= (__builtin_bit_cast(unsigned, t[8 + i]) & 127u) << (8 * i); w3 |= (__builtin_bit_cast(unsigned, t[12 + i]) & 127u) << (8 * i); }
          idxb[lane * 4 + 0] = w0; idxb[lane * 4 + 1] = w1; idxb[lane * 4 + 2] = w2; idxb[lane * 4 + 3] = w3; }
        float s2[16];
#pragma unroll
        for (int i = 0; i < 16; ++i) { t[i] = packf(t[i], 0u, 127u); s2[i] = __shfl_xor(t[i], 1); }
        float cd[16], cb[16], cc_[16], cx[2];
        { int n = 0;
#pragma unroll
          for (int a = 0; a < 16; ++a)
#pragma unroll
            for (int b = 0; b < 16; ++b) if ((a + 1) * (b + 1) <= 16) { const float v_ = packf(t[a] + s2[b], (unsigned)(a * 16 + b), 255u);
                if (n < 16) cd[n] = v_; else if (n < 32) cb[n - 16] = v_; else if (n < 48) cc_[n - 32] = v_; else cx[n - 48] = v_;
                ++n; } }
        sort16_desc(cd); sort16_desc(cb); sort16_desc(cc_);
        merge16_desc(cd, cb); merge16_desc(cd, cc_);
        INS16(cd, cx[0]); INS16(cd, cx[1]);
        LDS_WAIT(); asm volatile("" ::: "memory");
        if ((lane & 1) == 0) {
            const int tl_ = lane >> 4; const float rs = rsqrtf(fx_get((const u64*)(ws + WS_SSQ2) + tok0 + tl_) * (1.0f / 1024.0f) + EPS) * 1.4426950408889634f;
            const float m = packf(cd[0], 0u, 255u); float e[16], sum = 0.f;
#pragma unroll
            for (int i = 0; i < 16; ++i) { e[i] = __builtin_amdgcn_exp2f((packf(cd[i], 0u, 255u) - m) * rs); sum += e[i]; }
            const float inv = 1.0f / sum;
            const int tl = lane >> 4, head = (lane >> 1) & 7;
            const LAS unsigned char* ib = (const LAS unsigned char*)idxb;
            unsigned ids[16];
#pragma unroll
            for (int i = 0; i < 16; ++i) { const unsigned code = __builtin_bit_cast(unsigned, cd[i]) & 255u, a = code >> 4, b = code & 15u;
                ids[i] = (unsigned)ib[lane * 16 + a] * 128u + (unsigned)ib[(lane + 1) * 16 + b]; e[i] *= inv; }
            v4u* pi = (v4u*)((unsigned short*)SELI + (size_t)(tok0 + tl) * 128 + head * 16); f32x4* pw = (f32x4*)(SELW + (size_t)(tok0 + tl) * 128 + head * 16);
            pi[0] = (v4u){ids[0] | (ids[1] << 16), ids[2] | (ids[3] << 16), ids[4] | (ids[5] << 16), ids[6] | (ids[7] << 16)};
            pi[1] = (v4u){ids[8] | (ids[9] << 16), ids[10] | (ids[11] << 16), ids[12] | (ids[13] << 16), ids[14] | (ids[15] << 16)};
#pragma unroll
            for (int i = 0; i < 4; ++i) pw[i] = (f32x4){e[4 * i], e[4 * i + 1], e[4 * i + 2], e[4 * i + 3]};
        }
        LDS_WAIT(); asm volatile("" ::: "memory");
    }
}

#define TR16(acc, o0, o1, M2, M1, M0) do { float r8_[8], r4_[4]; \
    { const bool up_ = (lane & (M2)) != 0; _Pragma("unroll") for (int i_ = 0; i_ < 8; ++i_) { const float s_ = up_ ? acc[i_] : acc[8 + i_]; const float k_ = up_ ? acc[8 + i_] : acc[i_]; r8_[i_] = k_ + __shfl_xor(s_, (M2)); } } \
    { const bool up_ = (lane & (M1)) != 0; _Pragma("unroll") for (int i_ = 0; i_ < 4; ++i_) { const float s_ = up_ ? r8_[i_] : r8_[4 + i_]; const float k_ = up_ ? r8_[4 + i_] : r8_[i_]; r4_[i_] = k_ + __shfl_xor(s_, (M1)); } } \
    { const bool up_ = (lane & (M0)) != 0; const float s0_ = up_ ? r4_[0] : r4_[2], k0_ = up_ ? r4_[2] : r4_[0], s1_ = up_ ? r4_[1] : r4_[3], k1_ = up_ ? r4_[3] : r4_[1]; \
      o0 = k0_ + __shfl_xor(s0_, (M0)); o1 = k1_ + __shfl_xor(s1_, (M0)); } } while (0)

#define XSUM32(a, b) ({ const auto r_ = __builtin_amdgcn_permlane32_swap((unsigned)(a), (unsigned)(b), false, false); (int)(r_[0] + r_[1]); })
#define XSUM16(a, b) ({ const auto r_ = __builtin_amdgcn_permlane16_swap((unsigned)(a), (unsigned)(b), false, false); (int)(r_[0] + r_[1]); })
#define ROR8(v) __builtin_amdgcn_update_dpp(0, (int)(v), 0x128, 0xf, 0xf, false)

#define STAGE() __builtin_amdgcn_sched_barrier(0)
#define VINIT(x, y) asm volatile("v_mov_b32 %0, %1" : "=v"(x) : "v"(y))
__device__ __forceinline__ void u4_token(const v4u (&R)[16], const v4u (&xc)[2], int lane, float* dst) {
#define SD4(a, b, c) __builtin_amdgcn_sdot4((int)(a), (int)(b), (c), false)
    const unsigned X[8] = {xc[0].x, xc[0].y, xc[0].z, xc[0].w, xc[1].x, xc[1].y, xc[1].z, xc[1].w};
    int sl_ = SD4(X[0], 0x01010101, 0), sl2_ = SD4(X[2], 0x01010101, 0), sh_ = SD4(X[1], 0x01010101, 0), sh2_ = SD4(X[3], 0x01010101, 0);
    STAGE();
    sl_ = SD4(X[4], 0x01010101, sl_); sl2_ = SD4(X[6], 0x01010101, sl2_); sh_ = SD4(X[5], 0x01010101, sh_); sh2_ = SD4(X[7], 0x01010101, sh2_);
    STAGE();
    const int c0 = 8 * (sh_ + sh2_) - 120 * (sl_ + sl2_), zero_ = 0;
    int acc[16];
#pragma unroll
    for (int g = 0; g < 4; ++g) {
        unsigned aL[4][4], aH[4][4]; int lo[4], hi[4];
#pragma unroll
        for (int r = 0; r < 4; ++r) { const v4u w_ = R[4 * g + r]; const unsigned ww[4] = {w_.x, w_.y, w_.z, w_.w};
#pragma unroll
            for (int d = 0; d < 4; ++d) { aL[r][d] = ww[d] & 0x0F0F0F0Fu; aH[r][d] = ww[d] & 0xF0F0F0F0u; }
            VINIT(lo[r], zero_); VINIT(hi[r], c0); }
        STAGE();
#pragma unroll
        for (int r = 0; r < 4; ++r) { lo[r] = SD4(aL[r][0], X[0], lo[r]); hi[r] = SD4(aH[r][0], X[1], hi[r]); }
        STAGE();
#pragma unroll
        for (int r = 0; r < 4; ++r) { lo[r] = SD4(aL[r][1], X[2], lo[r]); hi[r] = SD4(aH[r][1], X[3], hi[r]); }
        STAGE();
#pragma unroll
        for (int r = 0; r < 4; ++r) { lo[r] = SD4(aL[r][2], X[4], lo[r]); hi[r] = SD4(aH[r][2], X[5], hi[r]); }
        STAGE();
#pragma unroll
        for (int r = 0; r < 4; ++r) { lo[r] = SD4(aL[r][3], X[6], lo[r]); hi[r] = SD4(aH[r][3], X[7], hi[r]); }
        STAGE();
#pragma unroll
        for (int r = 0; r < 4; ++r) acc[4 * g + r] = (lo[r] << 4) + hi[r];
    }
#undef SD4
    STAGE();
    int k8[8], s8[8], r8[8], k4[4], s4[4], r4[4], o0, o1;
    { const bool up_ = (lane & 1) != 0;
#pragma unroll
      for (int i = 0; i < 8; ++i) { k8[i] = up_ ? acc[8 + i] : acc[i]; s8[i] = up_ ? acc[i] : acc[8 + i]; } }
    STAGE();
#pragma unroll
    for (int i = 0; i < 8; ++i) r8[i] = k8[i] + __builtin_amdgcn_update_dpp(0, s8[i], 0xB1, 0xf, 0xf, false);
    STAGE();
    { const bool up_ = (lane & 2) != 0;
#pragma unroll
      for (int i = 0; i < 4; ++i) { k4[i] = up_ ? r8[4 + i] : r8[i]; s4[i] = up_ ? r8[i] : r8[4 + i]; } }
    STAGE();
#pragma unroll
    for (int i = 0; i < 4; ++i) r4[i] = k4[i] + __builtin_amdgcn_update_dpp(0, s4[i], 0x4E, 0xf, 0xf, false);
    STAGE();
    { const bool up_ = (lane & 4) != 0; const int s0_ = up_ ? r4[0] : r4[2], s1_ = up_ ? r4[1] : r4[3], k0_ = up_ ? r4[2] : r4[0], k1_ = up_ ? r4[3] : r4[1];
      int x0_ = __builtin_amdgcn_update_dpp(0, s0_, 0x104, 0xf, 0x5, false); int x1_ = __builtin_amdgcn_update_dpp(0, s1_, 0x104, 0xf, 0x5, false);
      x0_ = __builtin_amdgcn_update_dpp(x0_, s0_, 0x114, 0xf, 0xA, false); x1_ = __builtin_amdgcn_update_dpp(x1_, s1_, 0x114, 0xf, 0xA, false);
      o0 = k0_ + x0_; o1 = k1_ + x1_; }
    const int cc = (lane & 1) * 8 + ((lane >> 1) & 1) * 4 + ((lane >> 2) & 1) * 2;
    *(f32x2*)(dst + cc) = (f32x2){(float)o0, (float)o1};
}
#define PEER_LD_IDS(dst, t) do { dst[0] = *(const v4u*)(SELI + (size_t)(t) * 128 + rg * 16); dst[1] = *(const v4u*)(SELI + (size_t)(t) * 128 + rg * 16 + 8); } while (0)
#define PEER_LD_ROWS16(dst, ids) do { _Pragma("unroll") for (int h_ = 0; h_ < 2; ++h_) { const v4u q_ = ids[h_]; \
        const unsigned e_[8] = {q_.x & 0xffffu, q_.x >> 16, q_.y & 0xffffu, q_.y >> 16, q_.z & 0xffffu, q_.z >> 16, q_.w & 0xffffu, q_.w >> 16}; \
        _Pragma("unroll") for (int i_ = 0; i_ < 8; ++i_) dst[h_ * 8 + i_] = *(const v4u*)(TAB + (size_t)e_[i_] * 128 + ch * 16); } } while (0)
__device__ __forceinline__ void peer_u4_pass(unsigned char* ws, int part, int wv, int nwv, int lane_) {
    int lane = lane_; asm volatile("" : "+v"(lane));
    const unsigned short* SELI = (const unsigned short*)(ws + WS_SELI);
    const unsigned char* H8 = ws + WS_H8 + part * 256;
    const unsigned char* TAB = ws + WS_PU4 + (size_t)part * 16384 * 128;
    float* PART = (float*)(ws + WS_PART) + (size_t)part * NTOK * 128;
    const int rg = lane >> 3, ch = lane & 7;
    if (wv >= NTOK) return;
#define LD_X(dst, t) do { const v4u* p_ = (const v4u*)(H8 + (size_t)(t) * 1024 + ch * 32); dst[0] = p_[0]; dst[1] = p_[1]; } while (0)
#define STEP(RC, RN, IDC, IDN, XC, XN, tk_) do { \
        { const int t1_ = ((tk_) + nwv < NTOK) ? (tk_) + nwv : (tk_), t2_ = ((tk_) + 2 * nwv < NTOK) ? (tk_) + 2 * nwv : (tk_); \
          PEER_LD_ROWS16(RN, IDN); PEER_LD_IDS(IDC, t2_); LD_X(XN, t1_); }                \
        asm volatile("" ::: "memory"); __builtin_amdgcn_sched_barrier(0); \
        u4_token(RC, XC, lane, PART + (size_t)(tk_) * 128 + rg * 16); \
        __builtin_amdgcn_sched_barrier(0); \
        asm volatile("" : "+v"(XN[0]), "+v"(XN[1]), "+v"(IDC[0]), "+v"(IDC[1])); } while (0)
    v4u idA[2], idB[2], xA[2], xB[2], RA[16], RB[16];
    PEER_LD_IDS(idA, wv); LD_X(xA, wv);
    { const int t1 = (wv + nwv < NTOK) ? wv + nwv : wv; PEER_LD_IDS(idB, t1); }
    PEER_LD_ROWS16(RA, idA);
    for (int tk = wv; tk < NTOK; tk += 2 * nwv) {
        STEP(RA, RB, idA, idB, xA, xB, tk);
        if (tk + nwv < NTOK) STEP(RB, RA, idB, idA, xB, xA, tk + nwv);
    }
#undef LD_X
#undef STEP
}

__device__ __forceinline__ void v4_grp(const v4u& R0, const v4u& R1, const v4u& R2, const v4u& R3, unsigned Wq, int (&alo)[16], int (&ahi)[16]) {
    const unsigned r0[4] = {R0.x, R0.y, R0.z, R0.w}, r1[4] = {R1.x, R1.y, R1.z, R1.w}, r2[4] = {R2.x, R2.y, R2.z, R2.w}, r3[4] = {R3.x, R3.y, R3.z, R3.w};
    unsigned A[4], B[4], C[4], D[4], T[16], L[16];
#pragma unroll
    for (int d = 0; d < 4; ++d) { A[d] = __builtin_amdgcn_perm(r1[d], r0[d], 0x05010400u); B[d] = __builtin_amdgcn_perm(r1[d], r0[d], 0x07030602u);
                                  C[d] = __builtin_amdgcn_perm(r3[d], r2[d], 0x05010400u); D[d] = __builtin_amdgcn_perm(r3[d], r2[d], 0x07030602u); }
    STAGE();
#pragma unroll
    for (int d = 0; d < 4; ++d) { T[d * 4 + 0] = __builtin_amdgcn_perm(C[d], A[d], 0x05040100u); T[d * 4 + 1] = __builtin_amdgcn_perm(C[d], A[d], 0x07060302u);
                                  T[d * 4 + 2] = __builtin_amdgcn_perm(D[d], B[d], 0x05040100u); T[d * 4 + 3] = __builtin_amdgcn_perm(D[d], B[d], 0x07060302u); }
    STAGE();
#pragma unroll
    for (int i = 0; i < 16; ++i) L[i] = T[i] & 0x0F0F0F0Fu;
    STAGE();
#pragma unroll
    for (int i = 0; i < 16; ++i) { alo[i] = __builtin_amdgcn_sdot4((int)L[i], (int)Wq, alo[i], false);
                                   ahi[i] = __builtin_amdgcn_sdot4((int)T[i], (int)Wq, ahi[i], false); }
    STAGE();
}
__device__ __forceinline__ void v4_token(const v4u (&R)[16], const v4u& wc, float osc, int lane, _Float16* dst) {
    int alo[16], ahi[16];
#pragma unroll
    for (int i = 0; i < 16; ++i) { VINIT(alo[i], 0); VINIT(ahi[i], 0); }
    STAGE();
    v4_grp(R[0], R[1], R[2], R[3], wc.x, alo, ahi); v4_grp(R[4], R[5], R[6], R[7], wc.y, alo, ahi);
    v4_grp(R[8], R[9], R[10], R[11], wc.z, alo, ahi); v4_grp(R[12], R[13], R[14], R[15], wc.w, alo, ahi);
    int sw_ = __builtin_amdgcn_sdot4((int)wc.x, 0x01010101, 0, false); sw_ = __builtin_amdgcn_sdot4((int)wc.y, 0x01010101, sw_, false);
    sw_ = __builtin_amdgcn_sdot4((int)wc.z, 0x01010101, sw_, false); sw_ = __builtin_amdgcn_sdot4((int)wc.w, 0x01010101, sw_, false);
    int cv[32];
#pragma unroll
    for (int d = 0; d < 4; ++d)
#pragma unroll
        for (int j = 0; j < 4; ++j) { cv[8 * d + j] = (alo[d * 4 + j] << 4) - 120 * sw_; cv[8 * d + 4 + j] = (ahi[d * 4 + j] - alo[d * 4 + j]) + 8 * sw_; }
    STAGE();
    unsigned xa[16], xb[16]; int r16[16], r8[8], k4[4], s4[4]; f32x4 o;
#pragma unroll
    for (int i = 0; i < 16; ++i) { const auto r_ = __builtin_amdgcn_permlane32_swap((unsigned)cv[i], (unsigned)cv[16 + i], false, false); xa[i] = r_[0]; xb[i] = r_[1]; }
    STAGE();
#pragma unroll
    for (int i = 0; i < 16; ++i) r16[i] = (int)(xa[i] + xb[i]);
    STAGE();
#pragma unroll
    for (int i = 0; i < 8; ++i) { const auto r_ = __builtin_amdgcn_permlane16_swap((unsigned)r16[i], (unsigned)r16[8 + i], false, false); xa[i] = r_[0]; xb[i] = r_[1]; }
    STAGE();
#pragma unroll
    for (int i = 0; i < 8; ++i) r8[i] = (int)(xa[i] + xb[i]);
    STAGE();
    { const bool up_ = (lane & 8) != 0;
#pragma unroll
      for (int i = 0; i < 4; ++i) { k4[i] = up_ ? r8[4 + i] : r8[i]; s4[i] = up_ ? r8[i] : r8[4 + i]; } }
    STAGE();
#pragma unroll
    for (int i = 0; i < 4; ++i) o[i] = (float)(k4[i] + ROR8(s4[i])) * osc;
    const int cc = ((lane >> 5) & 1) * 16 + ((lane >> 4) & 1) * 8 + ((lane >> 3) & 1) * 4;
    *(v2u*)(dst + cc) = (v2u){pkh2(o[0], o[1]), pkh2(o[2], o[3])};
}
__device__ __forceinline__ void peer_v4_pass(unsigned char* ws, int part, int wv, int nwv, int lane_) {
    int lane = lane_; asm volatile("" : "+v"(lane));
    const unsigned short* SELI = (const unsigned short*)(ws + WS_SELI);
    const unsigned char* W8 = ws + WS_SELW; const float* WSC = (const float*)(ws + WS_WSC);
    const unsigned char* TAB = ws + WS_PV4 + (size_t)part * 16384 * 128;
    _Float16* POUT = (_Float16*)(ws + WS_POUT) + part * 256;
    const float vstep = U4_STEP * sqrtf(fx_get((const u64*)(ws + WS_TSC) + 1) * (1.0f / (1024.0f * 1024.0f))) * (1.0f / 16.0f);
    const int rg = lane >> 3, ch = lane & 7;
    if (wv >= NTOK) return;
#define LD_W(dst, sc, t) do { dst = *(const v4u*)(W8 + (size_t)(t) * 128 + rg * 16); sc = WSC[t]; } while (0)
#define STEP(RC, RN, IDC, IDN, WC, SC_, WN, SN, tk_) do { \
        { const int t1_ = ((tk_) + nwv < NTOK) ? (tk_) + nwv : (tk_), t2_ = ((tk_) + 2 * nwv < NTOK) ? (tk_) + 2 * nwv : (tk_); \
          PEER_LD_ROWS16(RN, IDN); PEER_LD_IDS(IDC, t2_); LD_W(WN, SN, t1_); }            \
        asm volatile("" ::: "memory"); __builtin_amdgcn_sched_barrier(0); \
        v4_token(RC, WC, SC_ * vstep, lane, POUT + (size_t)(tk_) * 1024 + ch * 32); \
        __builtin_amdgcn_sched_barrier(0); \
        asm volatile("" : "+v"(WN), "+v"(SN), "+v"(IDC[0]), "+v"(IDC[1])); } while (0)
    v4u idA[2], idB[2], wA, wB, RA[16], RB[16]; float sA, sB;
    PEER_LD_IDS(idA, wv); LD_W(wA, sA, wv);
    { const int t1 = (wv + nwv < NTOK) ? wv + nwv : wv; PEER_LD_IDS(idB, t1); }
    PEER_LD_ROWS16(RA, idA);
    for (int tk = wv; tk < NTOK; tk += 2 * nwv) {
        STEP(RA, RB, idA, idB, wA, sA, wB, sB, tk);
        if (tk + nwv < NTOK) STEP(RB, RA, idB, idA, wB, sB, wA, sA, tk + nwv);
    }
#undef LD_W
#undef STEP
}

__device__ __forceinline__ void peer_combine(unsigned char* ws, int gtid, int nthreads) {
    const f32x4* PART = (const f32x4*)(ws + WS_PART); const f32x4* SELG = (const f32x4*)(ws + WS_SELG); unsigned* SELW = (unsigned*)(ws + WS_SELW); float* WSC = (float*)(ws + WS_WSC);
    const u64* ssq2 = (const u64*)(ws + WS_SSQ2); const u64* ssq1 = (const u64*)(ws + WS_SSQ1);
    const float ustep = U4_STEP * sqrtf(fx_get((const u64*)(ws + WS_TSC)) * (1.0f / (1024.0f * 1024.0f))) * (1.0f / 16.0f);
    for (int i = gtid; i < NTOK * 32; i += nthreads) {
        f32x4 s = PART[i];
#pragma unroll
        for (int p = 1; p < 4; ++p) s += PART[(size_t)p * NTOK * 32 + i];
        const float sc = rsqrtf(fx_get(ssq2 + (i >> 5)) * (1.0f / 1024.0f) + EPS) * (sqrtf(fx_get(ssq1 + (i >> 5)) * (1.0f / 1024.0f) + EPS) * (1.0f / H8_SCALE)) * ustep;
        const f32x4 g = SELG[i];
        const float w0 = g[0] * gelu_tanh(s[0] * sc), w1 = g[1] * gelu_tanh(s[1] * sc), w2 = g[2] * gelu_tanh(s[2] * sc), w3 = g[3] * gelu_tanh(s[3] * sc);
        float mx = fmaxf(fmaxf(fabsf(w0), fabsf(w1)), fmaxf(fabsf(w2), fabsf(w3)));
#pragma unroll
        for (int o = 1; o < 32; o <<= 1) mx = fmaxf(mx, __shfl_xor(mx, o));
        mx = fmaxf(mx, 1.0e-30f); const float q = 127.0f / mx; unsigned pw = 0u;
        pw = __builtin_amdgcn_cvt_pk_u8_f32(__builtin_rintf(w0 * q) + 128.0f, 0, pw); pw = __builtin_amdgcn_cvt_pk_u8_f32(__builtin_rintf(w1 * q) + 128.0f, 1, pw);
        pw = __builtin_amdgcn_cvt_pk_u8_f32(__builtin_rintf(w2 * q) + 128.0f, 2, pw); pw = __builtin_amdgcn_cvt_pk_u8_f32(__builtin_rintf(w3 * q) + 128.0f, 3, pw);
        SELW[i] = pw ^ 0x80808080u; if ((i & 31) == 0) WSC[i >> 5] = mx * (1.0f / 127.0f);
    }
}

__device__ __forceinline__ void final_norm_row(const bf16* hrow, const _Float16* prow, const float* gain, float* orow, int lane) {
    const v2u* xr = (const v2u*)hrow + lane; const u64* pr = (const u64*)prow + lane;     const f32x4* gr = (const f32x4*)gain + lane;
    f32x4 v[4]; float s = 0.f;
#pragma unroll
    for (int j = 0; j < 4; ++j) { const v2u hw = xr[64 * j]; const u64 pw = pr[64 * j]; const h2_t pa = __builtin_bit_cast(h2_t, (unsigned)pw), pb = __builtin_bit_cast(h2_t, (unsigned)(pw >> 32)); v[j] = (f32x4){bf_lo(hw.x) + (float)pa.x, bf_hi(hw.x) + (float)pa.y, bf_lo(hw.y) + (float)pb.x, bf_hi(hw.y) + (float)pb.y}; s += (v[j].x * v[j].x + v[j].y * v[j].y) + (v[j].z * v[j].z + v[j].w * v[j].w); }
    const float rstd = rsqrtf(wave_sum(s) * (1.f / 1024.f) + EPS);
    f32x4* o = (f32x4*)orow + lane;
#pragma unroll
    for (int j = 0; j < 4; ++j) { const f32x4 gg = gr[64 * j]; o[64 * j] = (f32x4){v[j].x * rstd * gg.x, v[j].y * rstd * gg.y, v[j].z * rstd * gg.z, v[j].w * rstd * gg.w}; }
}

__global__ void __launch_bounds__(NWAVES * 64, 2) fwd_megakernel(Args args) {
    extern __shared__ __attribute__((aligned(16))) unsigned char lds[];
    LAS unsigned char* L = (LAS unsigned char*)lds;
    volatile LAS unsigned* MISC = (volatile LAS unsigned*)(L + MISC_OFF);
    const int wave = __builtin_amdgcn_readfirstlane((int)threadIdx.x >> 6);
#define FRESH_LANE() ({ int l_ = (int)__builtin_amdgcn_mbcnt_hi(~0u, __builtin_amdgcn_mbcnt_lo(~0u, 0u)); asm volatile("" : "+v"(l_)); l_; })
    const int G = gridDim.x, bx = blockIdx.x;
    const int vcu = (G % 8 == 0) ? (bx % 8) * (G / 8) + bx / 8 : bx;
    unsigned char* ws = args.ws;
    gu32* ctl = (gu32*)(ws + WS_CTL);
    for (int u = (int)threadIdx.x; u < (LDS_BYTES - LDSCTL_OFF) / 4; u += NWAVES * 64) ((LAS unsigned*)(L + LDSCTL_OFF))[u] = 0u;
    __syncthreads();
    XcdBarrier bar = xcd_barrier_post((unsigned*)(ctl + CW_BAR), MISC + 8);
    const int gw = vcu * NWAVES + wave, NGW = G * NWAVES;

    const float* x = (const float*)args.in[0];
    EpiArgs E;
    E.ws = ws; E.b_gate = (const float*)args.in[5]; E.x = x; E.lam_re = (const float*)args.in[6]; E.lam_im = (const float*)args.in[7]; E.log_dt = (const float*)args.in[8];

    for (int rep_ = 0; rep_ < ((REP & 8) ? 2 : 1); ++rep_) {
        const int lane = FRESH_LANE(), tid = wave * 64 + lane;
        LAS float* scr = (LAS float*)(L + wave * 16384);
        constexpr int I_IN = 16 * 101, I_GLU = 8 * 64, I_UQ = 6 * 24, I_UKV = 4 * 32, I_MO = 8 * 32, I_OUT = 16 * 32, I_MKV = 16 * 64, I_MO2 = 16 * 32;
        constexpr int NITEMS = I_IN + I_GLU + I_UQ + I_UKV + I_MO + I_OUT + I_MKV + I_MO2;
        auto do_transpose = [&](int it) {
            int r = it;
            if (r < I_IN) { transpose_item((const float*)args.in[4], 1024, 3232, (bf16*)(ws + W_IN), 1, nullptr, scr, r, lane); return; } r -= I_IN;
            if (r < I_GLU) { transpose_item((const float*)args.in[14], 512, 2048, (bf16*)(ws + W_GLU), 2, nullptr, scr, r, lane); return; } r -= I_GLU;
            if (r < I_UQ) { transpose_item((const float*)args.in[16], 384, 768, (bf16*)(ws + W_UQ), 3, (const float*)args.in[15], scr, r, lane); return; } r -= I_UQ;
            if (r < I_UKV) { transpose_item((const float*)args.in[18], 256, 1024, (bf16*)(ws + W_UKV), 4, (const float*)args.in[17], scr, r, lane); return; } r -= I_UKV;
            if (r < I_MO) { transpose_item((const float*)args.in[19], 512, 1024, (bf16*)(ws + W_MO), 0, nullptr, scr, r, lane); return; } r -= I_MO;
            if (r < I_OUT) { transpose_item((const float*)args.in[20], 1024, 1024, (bf16*)(ws + W_OUT), 0, nullptr, scr, r, lane); return; } r -= I_OUT;
            if (r < I_MKV) { transpose_item((const float*)args.in[24], 1024, 2048, (bf16*)(ws + W_MKV), 0, nullptr, scr, r, lane); return; } r -= I_MKV;
            transpose_item((const float*)args.in[25], 1024, 1024, (bf16*)(ws + W_MO2), 0, nullptr, scr, r, lane);
        };
        { v4u* z = (v4u*)(ws + W_IN + (size_t)928 * 1024 * 2); const int n16 = 96 * 1024 * 2 / 16;
          for (int i = bx * 512 + tid; i < n16; i += G * 512) z[i] = (v4u){0u, 0u, 0u, 0u}; }
        for (int pr_ = 0; pr_ < (PRO_REP == 2 ? 2 : 1); ++pr_)
        { const int n8a = 1024 * 1024 / 8, n8b = 1024 * 2048 / 8;
          for (int i = bx * 512 + tid; i < n8a + n8b; i += G * 512) {
              const bool qa = i < n8a; const int j = qa ? i : i - n8a; const int k = qa ? (j >> 7) : (j >> 8);
              const float* src = (qa ? (const float*)args.in[23] : (const float*)args.in[27]) + (size_t)j * 8; const float gk = ((const float*)args.in[qa ? 21 : 26])[k];
              const f32x4 a = *(const f32x4*)src * gk, b = *(const f32x4*)(src + 4) * gk;
              *(v4u*)((bf16*)(ws + (qa ? W_MQN : W_PQN)) + (size_t)j * 8) = (v4u){pk2(a[0], a[1]), pk2(a[2], a[3]), pk2(b[0], b[1]), pk2(b[2], b[3])}; } }
        { const float* sk = (const float*)args.in[28]; bf16* SK = (bf16*)(ws + W_SK);
          for (int i = bx * 512 + tid; i < 8 * 256 * 256 / 2; i += G * 512) { const int e = i * 2, h = e >> 16, n = (e >> 8) & 255, k = e & 255, s = n >> 7;
            unsigned w = 0u; if ((k >> 7) == s) { const float* p = sk + ((size_t)((h * 2 + s) * 128 + (n & 127))) * 128 + (k & 127); w = pk2(p[0], p[1]); }
            *(unsigned*)(SK + e) = w; } }
        auto do_xn = [&](int m) { rms_rows2_to_bf16(x + (size_t)m * 1024, x + (size_t)(m + 1) * 1024, (const float*)args.in[3], (bf16*)(ws + WS_XN) + (size_t)m * 1024, (bf16*)(ws + WS_XN) + (size_t)(m + 1) * 1024, lane); };
        for (int m = 2 * gw; m < NMEM; m += 2 * NGW) rms_rows2_to_bf16((const float*)args.in[1] + (size_t)m * 1024, (const float*)args.in[1] + (size_t)(m + 1) * 1024, (const float*)args.in[22], (bf16*)(ws + WS_MEMN) + (size_t)m * 1024, (bf16*)(ws + WS_MEMN) + (size_t)(m + 1) * 1024, lane);
        for (int it = gw; it < 2048; it += NGW) { const bool isu = it < 1024; const float* row = (const float*)args.in[isu ? 29 : 30] + (size_t)((it & 1023) * 16) * 1024; float sq = 0.f;
#pragma unroll
            for (int k = 0; k < 4; ++k) { f32x4 a = *(const f32x4*)(row + k * 256 + lane * 4); if (isu) a *= *(const f32x4*)((const float*)args.in[26] + k * 256 + lane * 4); sq += (a[0] * a[0] + a[1] * a[1]) + (a[2] * a[2] + a[3] * a[3]); }
            sq = wave_sum(sq); if (lane == 0) fx_add((u64*)(ws + WS_TSC) + (isu ? 0 : 1), sq); }
        for (int pr_ = 0; pr_ < (PRO_REP == 4 ? 2 : 1); ++pr_)
        { const int* pos = (const int*)args.in[2]; f32x2* tab = (f32x2*)(ws + WS_TAB);
          for (int i = bx * 512 + tid; i < NTOK * 16; i += G * 512) { const int tk = i >> 4, f = i & 15;
            const float inv = 1.0f / exp2f((float)f * 0.830482023721841f); const float ang = (float)pos[tk] * inv; float sn, cs; sincos_rev(ang, sn, cs); tab[i] = (f32x2){cs, sn}; } }
        { SsmP P{(const float*)args.in[6], (const float*)args.in[7], (const float*)args.in[8], (const float*)args.in[9], (const float*)args.in[10], (const float*)args.in[11], (const float*)args.in[12], (const float*)args.in[13]};
          bf16* MF = (bf16*)(ws + WS_MFULL); bf16* WST = (bf16*)(ws + WS_WST);
          constexpr int NL = 32 * 63, NO = 32 * 32, NS = 32 * 2 * 64;
          auto do_ssm = [&](int it) {
              if (it < NL) ssm_lag_item(P, MF, it / 63, it % 63 - 31, scr, lane);
              else if (it < NL + NO) { const int r = it - NL; ssm_out_item(P, MF, r >> 5, r & 31, lane); }
              else { const int r = it - NL - NO; ssm_st_item(P, WST, r >> 7, (r >> 6) & 1, r & 63, lane); }
          };
          const int nXN = (NTOK / 2 + NGW - 1) / NGW, nT = (NITEMS + NGW - 1) / NGW, nS = (NL + NO + NS + NGW - 1) / NGW, s0 = (gw + NGW / 2) % NGW;
          int kmax = nXN; if (3 * nT > kmax) kmax = 3 * nT; if (((nS + 1) / 2) * 3 > kmax) kmax = ((nS + 1) / 2) * 3;
#pragma unroll 1
          for (int k = 0; k < kmax; ++k) {
              { const int m = 2 * (gw + k * NGW); if (m < NTOK) do_xn(m); }
              if (k % 3 == 0) { const int it = gw + (k / 3) * NGW; if (it < NITEMS) do_transpose(it); }
              else { const int it = s0 + ((k / 3) * 2 + (k % 3 - 1)) * NGW; if (it < NL + NO + NS) do_ssm(it); }
          }
        }
    }
    xcd_barrier(bar);

    pg8::GemmDesc g; int gi_ = 0;
#define GEMMC(cc, ...) do { g = pg8::GemmDesc{__VA_ARGS__}; const bool rp_ = (REPG < 0 || REPG == gi_); ++gi_; if (rp_ && (REP & 1)) pg8::gemm_phase<true>(L, g, E, G, (cc), 1); if (rp_ && (REP & 128)) pg8::gemm_phase<true>(L, g, E, G, (cc), 2); pg8::gemm_phase<true>(L, g, E, G, (cc)); } while (0)
#define GEMM(...) GEMMC(bx, __VA_ARGS__)
#if DEBUG_STAGE >= 1
    GEMM((const bf16*)(ws + WS_XN), nullptr, (const bf16*)(ws + W_IN), nullptr, 1024, 1024, 1024, 128, 13, 1, pg8::ORD_STD, pg8::EK_IN, 0, 0, 0, 0);
    GEMMC((bx + G / 2) % G, (const bf16*)(ws + WS_MEMN), nullptr, (const bf16*)(ws + W_MKV), nullptr, 1024, 1024, 1024, 8, 8, 1, pg8::ORD_STD, pg8::EK_MEMKV, 0, 0, 0, 0);
    GEMMC((bx + G / 4) % G, (const bf16*)(ws + W_SK), nullptr, (const bf16*)(ws + W_PQN), nullptr, 256, 2048, 256, 1, 4, 8, pg8::ORD_Z, pg8::EK_W1, 0, 65536, 256, 0);
    xcd_barrier(bar);
    GEMM((const bf16*)(ws + WS_U), nullptr, (const bf16*)(ws + WS_WST), nullptr, UPITCH, 512, 512, 4, 1, 32, pg8::ORD_Z, pg8::EK_SLOC, 1, (long)NCHUNK * UPITCH, (long)256 * 512, 0);
    GEMMC((bx + G / 2) % G, (const bf16*)(ws + WS_CQ), nullptr, (const bf16*)(ws + W_UQ), nullptr, 384, 384, 384, 128, 3, 1, pg8::ORD_STD, pg8::EK_Q, 0, 0, 0, 0);
    GEMM((const bf16*)(ws + WS_CKV), nullptr, (const bf16*)(ws + W_UKV), nullptr, 256, 256, 256, 128, 4, 1, pg8::ORD_STD, pg8::EK_KV, 0, 0, 0, 0);
    xcd_barrier(bar);
    {
        const int xg = vcu >> 5, jj = vcu & 31;
        for (int i_ = 0; i_ < ((REP & 2) ? 8 : 4); ++i_) { const int i = i_ & 3;
            const int ui = i * 32 + jj, pair = xg * 8 + (ui >> 4), qb = ui & 15;
            if (pair < 64) {
                const int b = pair >> 3, h = pair & 7;
                const bf16* Qp = (const bf16*)(ws + WS_Q) + ((size_t)(pair * SEQ + qb * 256)) * 96;
                const bf16* Kp = (const bf16*)(ws + WS_K) + (size_t)pair * SEQ * 96;
                const bf16* Vp = (const bf16*)(ws + WS_V) + (size_t)pair * SEQ * 64;
                bf16* Op = (bf16*)(ws + WS_ATT) + ((size_t)(b * SEQ + qb * 256)) * 512 + h * 64;
                att::attn_unit(Qp, Kp, Vp, Op, (char*)lds);
            }
        }
    }
    GEMM((const bf16*)(ws + WS_U), nullptr, (const bf16*)(ws + WS_MFULL), nullptr, UPITCH, UPITCH, 768, 4, 2, 32, pg8::ORD_Z, pg8::EK_Y, 0, (long)NCHUNK * UPITCH, (long)512 * UPITCH, 0);
    GEMM((const bf16*)(ws + WS_KM), nullptr, (const bf16*)(ws + W_MQN), nullptr, 256, 1024, 256, 8, 4, 4, pg8::ORD_Z, pg8::EK_W2, 0, (long)8 * 65536, 256, 0);
    GEMMC((bx + G / 2) % G, (const bf16*)(ws + W_MO2), nullptr, (const bf16*)(ws + WS_VT), nullptr, 1024, 256, 256, 4, 8, 4, pg8::ORD_Z, pg8::EK_W3, 0, 256, (long)8 * 65536, 0);
    xcd_barrier(bar);
    GEMM((const bf16*)(ws + WS_YS), (const bf16*)(ws + WS_ATT), (const bf16*)(ws + W_GLU), (const bf16*)(ws + W_MO), 512, 512, 512, 128, 4, 1, pg8::ORD_DUAL, pg8::EK_P4, 0, 0, 0, 0);
    xcd_barrier(bar);
    GEMM((const bf16*)(ws + WS_MERGED), nullptr, (const bf16*)(ws + W_OUT), nullptr, 1024, 1024, 1024, 128, 4, 1, pg8::ORD_STD, pg8::EK_OUT, 0, 0, 0, 0);
    xcd_barrier(bar);
#endif
#if DEBUG_STAGE >= 2
    GEMM((const bf16*)(ws + WS_HB), nullptr, (const bf16*)(ws + WS_W2), nullptr, 1024, 1024, 1024, 128, 4, 1, pg8::ORD_STD, pg8::EK_MS2, 0, 0, 0, (long)1024 * 1024);
    xcd_barrier(bar);
    GEMM((const bf16*)(ws + WS_PM), nullptr, (const bf16*)(ws + WS_W3), nullptr, 1024, 1024, 1024, 128, 4, 1, pg8::ORD_STD, pg8::EK_MO, 0, 0, 0, (long)1024 * 1024);
#if DEBUG_STAGE >= 9
    { const int tid_ = wave * 64 + FRESH_LANE(); const f32x4* pu = (const f32x4*)args.in[29]; const f32x4* pv = (const f32x4*)args.in[30];
      const float uinv = 1.0f / (U4_STEP * sqrtf(fx_get((const u64*)(ws + WS_TSC)) * (1.0f / (1024.0f * 1024.0f)))), vinv = 1.0f / (U4_STEP * sqrtf(fx_get((const u64*)(ws + WS_TSC) + 1) * (1.0f / (1024.0f * 1024.0f))));
      const int n32 = 16384 * 1024 / 32;
      for (int i = bx * 512 + tid_; i < n32; i += G * 512) {
          const int e = i >> 5, col = (i & 31) * 32; const f32x4* gq = (const f32x4*)((const float*)args.in[26] + col); unsigned du[4], dv[4]; f32x4 ru[8], rv[8];
#pragma unroll
          for (int d = 0; d < 8; ++d) { ru[d] = pu[8 * i + d]; rv[d] = pv[8 * i + d]; }
#pragma unroll
          for (int d = 0; d < 4; ++d) { const f32x4 a = ru[2 * d] * gq[2 * d] * uinv, b = ru[2 * d + 1] * gq[2 * d + 1] * uinv, a2 = rv[2 * d] * vinv, b2 = rv[2 * d + 1] * vinv; unsigned w = 0u, w2 = 0u;
#pragma unroll
              for (int j = 0; j < 4; ++j) {
                  const int na = (int)__builtin_amdgcn_fmed3f(__builtin_floorf(a[j]), -8.0f, 7.0f), nb = (int)__builtin_amdgcn_fmed3f(__builtin_floorf(b[j]), -8.0f, 7.0f);
                  const int na2 = (int)__builtin_amdgcn_fmed3f(__builtin_floorf(a2[j]), -8.0f, 7.0f), nb2 = (int)__builtin_amdgcn_fmed3f(__builtin_floorf(b2[j]), -8.0f, 7.0f);
                  w |= ((unsigned)(na + 8) << (8 * j)) | (((unsigned)nb & 15u) << (8 * j + 4)); w2 |= ((unsigned)(na2 + 8) << (8 * j)) | (((unsigned)nb2 & 15u) << (8 * j + 4)); }
              du[d] = w; dv[d] = w2; }
          const size_t off_ = ((size_t)((col >> 8) * 16384 + e)) * 128 + ((col & 255) >> 1);
          *(v4u*)(ws + WS_PU4 + off_) = (v4u){du[0], du[1], du[2], du[3]}; *(v4u*)(ws + WS_PV4 + off_) = (v4u){dv[0], dv[1], dv[2], dv[3]}; } }
#endif
    xcd_barrier(bar);
#endif
#if DEBUG_STAGE >= 9
    GEMM((const bf16*)(ws + WS_HB), nullptr, (const bf16*)(ws + WS_W1), nullptr, 1024, 1024, 1024, 128, 8, 1, pg8::ORD_STD, pg8::EK_PS2, 0, 0, 0, 0);
    xcd_barrier(bar);
    if (REP & 16) peer_topk(ws, L + wave * 16384, gw, NGW, FRESH_LANE());
    peer_topk(ws, L + wave * 16384, gw, NGW, FRESH_LANE());
    xcd_barrier(bar);
    { const bool xp = (G % 8 == 0); const int np = xp ? 1 : 4, wvp = xp ? ((bx >> 3) * 2 + (bx & 1)) * NWAVES + wave : gw, nwp = xp ? (G >> 2) * NWAVES : NGW;
      for (int p_ = 0; p_ < np * ((REP & 32) ? 2 : 1); ++p_) peer_u4_pass(ws, xp ? ((bx & 7) >> 1) : (p_ & 3), wvp, nwp, FRESH_LANE()); }
    xcd_barrier(bar);
    peer_combine(ws, bx * 512 + wave * 64 + FRESH_LANE(), G * 512);
    xcd_barrier(bar);
    { const bool xp = (G % 8 == 0); const int np = xp ? 1 : 4, wvp = xp ? ((bx >> 3) * 2 + (bx & 1)) * NWAVES + wave : gw, nwp = xp ? (G >> 2) * NWAVES : NGW;
      for (int p_ = 0; p_ < np * ((REP & 64) ? 2 : 1); ++p_) peer_v4_pass(ws, xp ? ((bx & 7) >> 1) : (p_ & 3), wvp, nwp, FRESH_LANE()); }
    xcd_barrier(bar);
    { const int lane = FRESH_LANE();
    for (int m = gw; m < NTOK; m += NGW) final_norm_row((const bf16*)(ws + WS_HB) + (size_t)m * 1024, (const _Float16*)(ws + WS_POUT) + (size_t)m * 1024, (const float*)args.in[31], args.out + (size_t)m * 1024, lane); }
#else
    {
        const float* src = (DEBUG_STAGE == 0) ? x : (const float*)(ws + WS_H); const int lane = FRESH_LANE();
        for (int m = gw; m < NTOK; m += NGW) rms_row_to_f32(src + (size_t)m * 1024, (const float*)args.in[31], args.out + (size_t)m * 1024, lane);
    }
#endif
#undef GEMM
#undef GEMMC
}

extern "C" void kernel_launch(void* const* d_in, const int* in_sizes, int n_in, void* d_out, int out_size, void* d_ws, size_t ws_size, hipStream_t stream) {
    static int grid = 0;
    if (grid == 0) {
        if (n_in != 32 || in_sizes[0] != NTOK * D || out_size != NTOK * D || ws_size < WS_END) {
            fprintf(stderr, "kernel_launch: unexpected shapes: n_in %d in0 %d out %d ws %zu (need %zu)\n", n_in, n_in > 0 ? in_sizes[0] : -1, out_size, ws_size, (size_t)WS_END); grid = -1; return; }
        int dev = 0, cus = 0, per_cu = 0;
        if (hipGetDevice(&dev) != hipSuccess || hipDeviceGetAttribute(&cus, hipDeviceAttributeMultiprocessorCount, dev) != hipSuccess) { grid = -1; return; }
        if (hipFuncSetAttribute((const void*)fwd_megakernel, hipFuncAttributeMaxDynamicSharedMemorySize, LDS_BYTES) != hipSuccess) { fprintf(stderr, "kernel_launch: hipFuncSetAttribute failed\n"); grid = -1; return; }
        if (hipOccupancyMaxActiveBlocksPerMultiprocessor(&per_cu, (const void*)fwd_megakernel, NWAVES * 64, LDS_BYTES) != hipSuccess || per_cu < 1) {
            fprintf(stderr, "kernel_launch: occupancy query reports %d blocks per CU\n", per_cu); per_cu = 1; }
        (void)hipGetLastError();
        grid = cus;
    }
    if (grid < 0) return;
    if (hipMemsetAsync((char*)d_ws + WS_CTL, 0, CTL_ZERO_BYTES, stream) != hipSuccess) { fprintf(stderr, "kernel_launch: memset failed\n"); return; }
    Args a{};
    for (int i = 0; i < 32; ++i) a.in[i] = d_in[i];
    a.out = (float*)d_out; a.ws = (unsigned char*)d_ws;
    void* kargs[] = {&a};
    hipError_t e = hipLaunchCooperativeKernel((const void*)fwd_megakernel, dim3(grid), dim3(NWAVES * 64), kargs, LDS_BYTES, stream);
    if (e != hipSuccess) fprintf(stderr, "kernel_launch: cooperative launch failed: %s (grid %d)\n", hipGetErrorString(e), grid);
}
```

```cpp
#include <hip/hip_runtime.h>
#include <hip/hip_bf16.h>
#include <cstdio>
#include <cstdint>

#ifndef REP
#define REP 0
#endif
#ifndef PRO_REP
#define PRO_REP 0
#endif
#ifndef REPG
#define REPG -1
#endif
#ifndef DEBUG_STAGE
#define DEBUG_STAGE 9
#endif

constexpr int D = 1024, BATCH = 8, SEQ = 4096, NTOK = BATCH * SEQ;
constexpr int MEMT = 256, NMEM = BATCH * MEMT;
constexpr int TCH = 32;
constexpr int NCHUNK = NTOK / TCH;
constexpr int UPITCH = 768;
constexpr float EPS = 1e-6f;

#define GAS __attribute__((address_space(1)))
#define LAS __attribute__((address_space(3)))
typedef unsigned short bf16;
typedef unsigned v4u __attribute__((ext_vector_type(4)));
typedef unsigned v2u __attribute__((ext_vector_type(2)));
typedef float f32x4 __attribute__((ext_vector_type(4)));
typedef float f32x2 __attribute__((ext_vector_type(2)));
typedef short bf16x8 __attribute__((ext_vector_type(8)));
typedef GAS unsigned gu32;
typedef _Float16 h2_t __attribute__((ext_vector_type(2)));
__device__ __forceinline__ unsigned pkh2(float a, float b) { h2_t h = {(_Float16)a, (_Float16)b}; return __builtin_bit_cast(unsigned, h); }
__device__ __forceinline__ void sincos_rev(float x, float& sn, float& cs) { float r = x * 0.15915494309189535f; r = r - floorf(r); sn = __builtin_amdgcn_sinf(r); cs = __builtin_amdgcn_cosf(r); }
#define RLX_AGENT __ATOMIC_RELAXED, __HIP_MEMORY_SCOPE_AGENT
#define LDS_WAIT() asm volatile("s_waitcnt lgkmcnt(0)" ::: "memory")
#define VM_WAIT() asm volatile("s_waitcnt vmcnt(0)" ::: "memory")

__device__ __forceinline__ unsigned f2bf(float f) { unsigned u = __builtin_bit_cast(unsigned, f); return (u + 0x7fffu + ((u >> 16) & 1u)) >> 16; }
typedef float f32x2_t_ __attribute__((ext_vector_type(2))); typedef __bf16 bf16x2_t_ __attribute__((ext_vector_type(2)));
__device__ __forceinline__ unsigned pk2(float lo, float hi) { const f32x2_t_ v = {lo, hi}; const bf16x2_t_ b = __builtin_convertvector(v, bf16x2_t_); return __builtin_bit_cast(unsigned, b); }
__device__ __forceinline__ float bf_lo(unsigned w) { return __builtin_bit_cast(float, w << 16); }
__device__ __forceinline__ float bf_hi(unsigned w) { return __builtin_bit_cast(float, w & 0xffff0000u); }
__device__ __forceinline__ float wave_sum(float v) {
#pragma unroll
    for (int o = 1; o < 64; o <<= 1) v += __shfl_xor(v, o);
    return v;
}
typedef unsigned long long u64;
__device__ __forceinline__ void fx_add(u64* p, float s) { atomicAdd(p, (u64)(long long)(s * 1073741824.0f)); }
__device__ __forceinline__ float fx_get(const u64* p) { return (float)(long long)(*p) * (1.0f / 1073741824.0f); }
__device__ __forceinline__ float sigmoidf_(float x) { return __builtin_amdgcn_rcpf(1.0f + __builtin_amdgcn_exp2f(-1.4426950408889634f * x)); }
__device__ __forceinline__ float gelu_tanh(float x) {
    const float u = 1.5957691216057308f * (x + 0.044715f * x * x * x);
    return x * __builtin_amdgcn_rcpf(1.0f + __builtin_amdgcn_exp2f(-1.4426950408889634f * u));
}

constexpr size_t MiB = 1u << 20;
constexpr size_t WS_CTL = 0;
constexpr size_t CTL_ZERO_BYTES = 4 * MiB;
constexpr size_t WS_SSQQ = 1 * MiB, WS_SSQKV = WS_SSQQ + 256 * 1024, WS_SSQ1 = WS_SSQKV + 256 * 1024, WS_SSQ2 = WS_SSQ1 + 256 * 1024;
constexpr size_t WS_ROWSUM = 2 * MiB;
constexpr size_t W_SK = 4 * MiB;
constexpr size_t W_PQN = 5 * MiB;
constexpr size_t W_MO2 = 9 * MiB;
constexpr size_t WS_TAB = 11 * MiB;
constexpr size_t W_IN = 15 * MiB;
constexpr size_t W_GLU = W_IN + (size_t)3328 * 1024 * 2;
constexpr size_t W_UQ = W_GLU + (size_t)2048 * 512 * 2;
constexpr size_t W_UKV = W_UQ + (size_t)768 * 384 * 2;
constexpr size_t W_MO = W_UKV + (size_t)1024 * 256 * 2;
constexpr size_t W_OUT = W_MO + (size_t)1024 * 512 * 2;
constexpr size_t W_MQN = W_OUT + (size_t)1024 * 1024 * 2;
constexpr size_t W_MKV = W_MQN + (size_t)1024 * 1024 * 2;
constexpr size_t W_END = W_MKV + (size_t)2048 * 1024 * 2;
static_assert(W_END <= 34 * MiB, "weights region");
constexpr size_t WS_PU4 = 12 * MiB;
constexpr size_t WS_TSC = 512 * 1024;
constexpr size_t WS_H8 = 110 * MiB;
constexpr float U4_STEP = 0.335f, H8_SCALE = 127.0f / 12.0f;
constexpr size_t WS_PV4 = 28 * MiB;
constexpr size_t WS_W1 = 494 * MiB;
constexpr size_t WS_W2 = 446 * MiB;
constexpr size_t WS_W3 = 462 * MiB;
constexpr size_t WS_KM = 34 * MiB, WS_VT = 38 * MiB, WS_MEMN = 42 * MiB;
constexpr size_t WS_DYN = 46 * MiB;
constexpr size_t WS_GATES = 46 * MiB;
constexpr size_t WS_MFULL = 174 * MiB;
constexpr size_t WS_WST = 198 * MiB;
constexpr size_t WS_U = 206 * MiB;
constexpr size_t WS_Q = 254 * MiB;
constexpr size_t WS_K = 302 * MiB;
constexpr size_t WS_V = 350 * MiB;
constexpr size_t WS_XN = 382 * MiB;
constexpr size_t WS_SLOC = 382 * MiB;
constexpr size_t WS_ATT = 382 * MiB;
constexpr size_t WS_YS = 414 * MiB;
constexpr size_t WS_CQ = 446 * MiB;
constexpr size_t WS_CKV = 470 * MiB;
constexpr size_t WS_MERGED = 254 * MiB;
constexpr size_t WS_H = 46 * MiB;
constexpr size_t WS_HB = 174 * MiB;
constexpr size_t WS_QM = 318 * MiB;
constexpr size_t WS_PM = 382 * MiB;
constexpr size_t WS_OM = 238 * MiB;
constexpr size_t WS_SC = 366 * MiB;
constexpr size_t WS_SELI = 238 * MiB;
constexpr size_t WS_SELG = 254 * MiB;
constexpr size_t WS_SELW = 270 * MiB;
constexpr size_t WS_WSC = 278 * MiB;
constexpr size_t WS_PART = 286 * MiB;
constexpr size_t WS_POUT = 286 * MiB;
constexpr size_t WS_END = 512 * MiB;
static_assert(WS_W1 + 4 * MiB <= WS_END && WS_SC + (size_t)NTOK * 2048 * 2 <= WS_W1 && WS_CKV + (size_t)NTOK * 256 * 2 <= WS_END && WS_POUT + (size_t)NTOK * 4096 <= WS_END, "ws map");

constexpr int CW_BAR = 4096;

constexpr int RING_BYTES = 131072;
constexpr int LDSCTL_OFF = RING_BYTES, MISC_OFF = LDSCTL_OFF + 320;
constexpr int LDS_BYTES = 147456;
constexpr int NWAVES = 8;

#define XB_TMO      128
#define XB_XCNT(j)  (256  + 64 * (j))
#define XB_XSUB(j)  (1280 + 64 * (j))
#define XB_XGEN(j)  (2304 + 64 * (j))
#define XB_TOP      3328
#define XB_TOPGEN   3392
#define XCD_BAR_WORDS 3456
#define XB_SPIN_CAP (1u << 20)
__device__ __forceinline__ unsigned xb_ld(unsigned* p)              { return __hip_atomic_load(p, __ATOMIC_RELAXED, __HIP_MEMORY_SCOPE_AGENT); }
__device__ __forceinline__ unsigned xb_add(unsigned* p, unsigned v) { return __hip_atomic_fetch_add(p, v, __ATOMIC_RELAXED, __HIP_MEMORY_SCOPE_AGENT); }
__device__ __forceinline__ unsigned xb_xcc_id() { return (unsigned)__builtin_amdgcn_s_getreg((3 << 11) | 20) & 0xFu; }
#define XB_SPIN(cond, bar) do { unsigned _sp = 0; while (cond) { __builtin_amdgcn_s_sleep(1); \
    if ((++_sp & 255u) == 0u) { if (xb_ld(&(bar)[XB_TMO])) break; if (_sp > XB_SPIN_CAP) { atomicAdd(&(bar)[XB_TMO], 1u); break; } } } } while (0)
struct XcdBarrier { unsigned* bar; unsigned x; volatile LAS unsigned* st; };
__device__ __forceinline__ XcdBarrier xcd_barrier_post(unsigned* bar, volatile LAS unsigned* st) {
    XcdBarrier b; b.bar = bar; b.x = xb_xcc_id(); b.st = st;
    if (threadIdx.x == 0) (void)xb_add(&bar[XB_XCNT(b.x)], 1u);
    return b;
}
__device__ __forceinline__ void xcd_barrier_complete(unsigned* bar, unsigned x, unsigned& nloc, unsigned& nx) {
    const unsigned G = gridDim.x * gridDim.y * gridDim.z;
    unsigned sum, cnt, mine, sp = 0u;
    for (;;) {
        sum = 0u; cnt = 0u; mine = 0u;
#pragma unroll
        for (unsigned j = 0; j < 16; ++j) { const unsigned c = xb_ld(&bar[XB_XCNT(j)]); sum += c; cnt += (c > 0u) ? 1u : 0u; mine = (j == x) ? c : mine; }
        if (sum == G) break;
        __builtin_amdgcn_s_sleep(1);
        if ((++sp & 255u) == 0u) { if (xb_ld(&bar[XB_TMO])) break; if (sp > XB_SPIN_CAP) { atomicAdd(&bar[XB_TMO], 1u); break; } }
    }
    nloc = mine > 0u ? mine : 1u; nx = cnt > 0u ? cnt : 1u;
}
__device__ __forceinline__ void xcd_barrier(const XcdBarrier& b) {
    asm volatile("s_waitcnt vmcnt(0)" ::: "memory");
    __syncthreads();
    if (threadIdx.x == 0) {
        unsigned* bar = b.bar;
        __builtin_amdgcn_s_waitcnt(0);
        unsigned nloc = b.st[0], nx = b.st[1];
        if (nloc == 0u) { xcd_barrier_complete(bar, b.x, nloc, nx); b.st[0] = nloc; b.st[1] = nx; }
        const unsigned old = xb_add(&bar[XB_XSUB(b.x)], 1u);
        const unsigned gen = old / nloc;
        if (old + 1u == (gen + 1u) * nloc) {
            __builtin_amdgcn_fence(__ATOMIC_RELEASE, "agent");
            asm volatile("s_waitcnt vmcnt(0)" ::: "memory");
            const unsigned og = xb_add(&bar[XB_TOP], 1u);
            const unsigned tg = og / nx;
            if (og + 1u == (tg + 1u) * nx) xb_add(&bar[XB_TOPGEN], 1u);
            else XB_SPIN(xb_ld(&bar[XB_TOPGEN]) == tg, bar);
            __builtin_amdgcn_fence(__ATOMIC_ACQUIRE, "agent");
            xb_add(&bar[XB_XGEN(b.x)], 1u);
            asm volatile("s_waitcnt vmcnt(0)" ::: "memory");
        } else {
            XB_SPIN(xb_ld(&bar[XB_XGEN(b.x)]) == gen, bar);
            __builtin_amdgcn_fence(__ATOMIC_ACQUIRE, "agent");
            asm volatile("s_waitcnt vmcnt(0)" ::: "memory");
        }
    }
    __syncthreads();
}

struct EpiArgs {
    unsigned char* ws;
    const float *b_gate, *x, *lam_re, *lam_im, *log_dt;
#define EP(name, type, off) __device__ __forceinline__ type* name() const { return (type*)(ws + (off)); }
    EP(U, bf16, WS_U) EP(CQ, bf16, WS_CQ) EP(CKV, bf16, WS_CKV) EP(Kb, bf16, WS_K) EP(Vb, bf16, WS_V) EP(Qb, bf16, WS_Q) EP(GATES, unsigned char, WS_GATES)
    EP(KM, bf16, WS_KM) EP(VT, bf16, WS_VT) EP(YS, bf16, WS_YS) EP(ATT, bf16, WS_ATT) EP(MERGED, bf16, WS_MERGED) EP(HB, bf16, WS_HB)
    EP(PM, bf16, WS_PM) EP(H8, unsigned char, WS_H8) EP(SC, _Float16, WS_SC) EP(W1, bf16, WS_W1) EP(W2, bf16, WS_W2) EP(W3, bf16, WS_W3)
    EP(ssq_q, u64, WS_SSQQ) EP(ssq_kv, u64, WS_SSQKV) EP(ssq1, u64, WS_SSQ1) EP(ssq2, u64, WS_SSQ2) EP(rowsum, u64, WS_ROWSUM) EP(SLOC, float, WS_SLOC) EP(H, float, WS_H)
    EP(tab, const f32x2, WS_TAB)
#undef EP
};

namespace pg8 {
#define PG8_LAS __attribute__((address_space(3)))
typedef unsigned short bf16_t;
typedef unsigned u32x4 __attribute__((ext_vector_type(4)));
constexpr int BM = 256, BK = 64, HALF = 128, HTB = HALF * BK * 2, STAGE_BYTES = 8 * HTB, NXCD = 8, WGM = 8;
constexpr int XCH_OFF_ = STAGE_BYTES + 1024;
__host__ __device__ __forceinline__ int lds_byte(int r, int c) { const int st = (r >> 4) * 2 + (c >> 5), rr = r & 15, cc = c & 31, ob = rr * 64 + cc * 2; return st * 1024 + (ob ^ (((ob >> 9) & 1) << 5)); }
__host__ __device__ __forceinline__ void stage_rc(int b, int& R, int& C) { const int st = b / 1024, sb = b % 1024, swz = sb ^ (((sb >> 9) & 1) << 5); R = (st >> 1) * 16 + swz / 64; C = (st & 1) * 32 + (swz % 64) / 2; }
__host__ __device__ __forceinline__ int perm32(int rho) { const int n = rho >> 4, i = rho & 15; return 8 * (i >> 2) + 4 * n + (i & 3); }

struct Unit { int pm, pn, z; };
enum { ORD_STD = 0, ORD_Z = 1, ORD_DUAL = 2 };
enum { EK_IN = 0, EK_MEMKV, EK_Q, EK_KV, EK_SLOC, EK_Y, EK_P4, EK_OUT, EK_MS2, EK_MO, EK_PS2, EK_W1, EK_W2, EK_W3 };
struct GemmDesc {
    const bf16_t *A0, *A1, *B0, *B1;
    int lda, ldb, K;
    int nM, nN, nZ, order, epi, after_drain;
    long sAz, sBz, sBb;
    __device__ __forceinline__ const char* aptr(const Unit& u) const {
        const bf16_t* a = (order == ORD_DUAL && u.z) ? A1 : A0;
        return (const char*)(a + ((order == ORD_DUAL) ? 0 : (long)u.z * sAz) + (long)u.pm * BM * lda); }
    __device__ __forceinline__ const char* bptr(const Unit& u) const {
        const bf16_t* b = (order == ORD_DUAL && u.z) ? B1 : B0;
        return (const char*)(b + ((order == ORD_DUAL) ? 0 : (long)u.z * sBz) + (long)(u.pm >> 4) * sBb + (long)u.pn * BM * ldb); }
    __device__ __forceinline__ bool next(int i, int G, int c, Unit& u) const {
        if (order == ORD_STD) {
            const int nwg = nM * nN; const long L = (long)i * G + c; if (L >= nwg) return false;
            int wgid = (int)L; { const int q = nwg / NXCD, r = nwg % NXCD, xcd = wgid % NXCD, off = wgid / NXCD; wgid = (xcd < r ? xcd * (q + 1) : r * (q + 1) + (xcd - r) * q) + off; }
            const int nig = WGM * nN, gid = wgid / nig, fm = gid * WGM, gsz = (nM - fm) < WGM ? (nM - fm) : WGM;
            u.pm = fm + ((wgid % nig) % gsz); u.pn = (wgid % nig) / gsz; u.z = 0; return true;
        } else if (order == ORD_Z) {
            const long L = (long)i * G + c; if (L >= (long)nZ * nM * nN) return false;
            const int l = (int)L; u.pn = l % nN; const int t = l / nN; u.pm = t % nM; u.z = t / nM; return true;
        } else {
            const int combos = nM * nN, combo = (i / 3) * G + c; if (combo >= combos) return false;
            const int sub = i % 3, pnp = combo / nM; u.pm = combo % nM;
            if (sub < 2) { u.pn = 2 * pnp + sub; u.z = 0; } else { u.pn = pnp; u.z = 1; }
            return true;
        }
    }
};

typedef f32x4 Acc[2][2][4][2];
__device__ __forceinline__ v4u pack8(const float* v) { v4u w; w.x = pk2(v[0], v[1]); w.y = pk2(v[2], v[3]); w.z = pk2(v[4], v[5]); w.w = pk2(v[6], v[7]); return w; }
#define LOADV(v, ai, bj, m) do { const f32x4 a_ = acc[ai][bj][m][0], b_ = acc[ai][bj][m][1]; v[0] = a_[0]; v[1] = a_[1]; v[2] = a_[2]; v[3] = a_[3]; v[4] = b_[0]; v[5] = b_[1]; v[6] = b_[2]; v[7] = b_[3]; } while (0)
__device__ __forceinline__ float quad_sum16(float s) { s += __shfl_xor(s, 16); s += __shfl_xor(s, 32); return s; }

__device__ __forceinline__ void rope8(float* v, const f32x2* tabrow, int fq) {
    const int ib = 8 * (fq & 1);
#pragma unroll
    for (int j = 0; j < 8; ++j) {
        const float other = __shfl_xor(v[j], 32);
        const f32x2 cs = tabrow[ib + j];
        v[j] = (fq < 2) ? (v[j] * cs.x - other * cs.y) : (v[j] * cs.x + other * cs.y);
    }
}

__device__ __forceinline__ void epilogue(const GemmDesc& g, const EpiArgs& E, const Acc& acc, const Unit& u, int wr, int wc, int fr, int fq, bool probe = false) {
    const int rbase = u.pm * BM + wr * 64 + fr;
    const int cw = wc * 32 + 8 * fq;
    float v[8];
    switch (g.epi) {
    case EK_IN: {
        const int pn = u.pn;
#pragma unroll
        for (int ai = 0; ai < 2; ++ai)
#pragma unroll
            for (int m = 0; m < 4; ++m) {
                const int r = rbase + ai * HALF + m * 16;
                if (pn < 2) {
#pragma unroll
                    for (int bj = 0; bj < 2; ++bj) { LOADV(v, ai, bj, m); const int col = pn * 256 + bj * HALF + cw, gq = col >> 4, c0 = col & 15;
                        *(v4u*)(E.U() + ((size_t)(gq * NCHUNK + (r >> 5)) * UPITCH + (r & 31) * 16 + c0)) = pack8(v); }
                } else if (pn == 2) {
                    float s = 0.f;
#pragma unroll
                    for (int bj = 0; bj < 2; ++bj) { LOADV(v, ai, bj, m);
#pragma unroll
                        for (int j = 0; j < 8; ++j) s += v[j] * v[j];
                        *(v4u*)(E.CQ() + (size_t)r * 384 + bj * HALF + cw) = pack8(v); }
                    s = quad_sum16(s); if (fq == 0 && !probe) fx_add(E.ssq_q() + r, s);
                } else if (pn == 3) {
                    LOADV(v, ai, 0, m); float s = 0.f;
#pragma unroll
                    for (int j = 0; j < 8; ++j) s += v[j] * v[j];
                    *(v4u*)(E.CQ() + (size_t)r * 384 + 256 + cw) = pack8(v);
                    s = quad_sum16(s); if (fq == 0 && !probe) fx_add(E.ssq_q() + r, s);
                    if (wc == 0) {
                        LOADV(v, ai, 1, m); rope8(v, E.tab() + (size_t)r * 16, fq);
                        const v4u w = pack8(v); const int b = r >> 12, t = r & 4095;
#pragma unroll
                        for (int h = 0; h < 8; ++h) *(v4u*)(E.Kb() + ((size_t)((b * 8 + h) * SEQ + t)) * 96 + 64 + 8 * fq) = w;
                    }
                } else if (pn == 4) {
                    float s = 0.f;
#pragma unroll
                    for (int bj = 0; bj < 2; ++bj) { LOADV(v, ai, bj, m);
#pragma unroll
                        for (int j = 0; j < 8; ++j) s += v[j] * v[j];
                        *(v4u*)(E.CKV() + (size_t)r * 256 + bj * HALF + cw) = pack8(v); }
                    s = quad_sum16(s); if (fq == 0 && !probe) fx_add(E.ssq_kv() + r, s);
                } else {
#pragma unroll
                    for (int bj = 0; bj < 2; ++bj) { LOADV(v, ai, bj, m); const int col = (pn - 5) * 256 + bj * HALF + cw;
                        const f32x4 b0 = *(const f32x4*)(E.b_gate + col), b1 = *(const f32x4*)(E.b_gate + col + 4);
                        v[0] = sigmoidf_(v[0] + b0[0]); v[1] = sigmoidf_(v[1] + b0[1]); v[2] = sigmoidf_(v[2] + b0[2]); v[3] = sigmoidf_(v[3] + b0[3]);
                        v[4] = sigmoidf_(v[4] + b1[0]); v[5] = sigmoidf_(v[5] + b1[1]); v[6] = sigmoidf_(v[6] + b1[2]); v[7] = sigmoidf_(v[7] + b1[3]);
                        unsigned q[8];
#pragma unroll
                        for (int j = 0; j < 8; ++j) q[j] = (unsigned)(v[j] * 255.0f + 0.5f);
                        *(v2u*)(E.GATES() + (size_t)r * 2048 + col) = (v2u){q[0] | (q[1] << 8) | (q[2] << 16) | (q[3] << 24), q[4] | (q[5] << 8) | (q[6] << 16) | (q[7] << 24)}; }
                }
            }
    } break;
    case EK_MEMKV: {
#pragma unroll
        for (int ai = 0; ai < 2; ++ai)
#pragma unroll
            for (int m = 0; m < 4; ++m) {
                const int r = rbase + ai * HALF + m * 16, b = r >> 8, key = r & 255;
#pragma unroll
                for (int bj = 0; bj < 2; ++bj) { LOADV(v, ai, bj, m); const int col = u.pn * 256 + bj * HALF + cw, c2 = col & 1023, h = c2 >> 8, d = c2 & 255;
                    *(v4u*)((col < 1024 ? E.KM() : E.VT()) + ((size_t)((h * 8 + b) * 256 + key)) * 256 + d) = pack8(v); }
            }
    } break;
    case EK_Q: {
        constexpr float QS = 0.10206207261596577f * 1.4426950408889634f;
#pragma unroll
        for (int ai = 0; ai < 2; ++ai)
#pragma unroll
            for (int m = 0; m < 4; ++m) {
                const int r = rbase + ai * HALF + m * 16, b = r >> 12, t = r & 4095;
                const float sc = rsqrtf(fx_get(E.ssq_q() + r) * (1.0f / 384.0f) + EPS) * QS;
#pragma unroll
                for (int bj = 0; bj < 2; ++bj) { LOADV(v, ai, bj, m);
#pragma unroll
                    for (int j = 0; j < 8; ++j) v[j] *= sc;
                    if (u.pn < 2) { const int col = u.pn * 256 + bj * HALF + cw, h = col >> 6, d = col & 63;
                        *(v4u*)(E.Qb() + ((size_t)((b * 8 + h) * SEQ + t)) * 96 + d) = pack8(v); }
                    else { const int h = 4 * bj + wc; rope8(v, E.tab() + (size_t)r * 16, fq);
                        *(v4u*)(E.Qb() + ((size_t)((b * 8 + h) * SEQ + t)) * 96 + 64 + 8 * fq) = pack8(v); }
                }
            }
    } break;
    case EK_KV: {
#pragma unroll
        for (int ai = 0; ai < 2; ++ai)
#pragma unroll
            for (int m = 0; m < 4; ++m) {
                const int r = rbase + ai * HALF + m * 16, b = r >> 12, t = r & 4095;
                const float sc = rsqrtf(fx_get(E.ssq_kv() + r) * (1.0f / 256.0f) + EPS);
#pragma unroll
                for (int bj = 0; bj < 2; ++bj) { LOADV(v, ai, bj, m);
#pragma unroll
                    for (int j = 0; j < 8; ++j) v[j] *= sc;
                    const int col = (u.pn & 1) * 256 + bj * HALF + cw, h = col >> 6, d = col & 63;
                    if (u.pn < 2) *(v4u*)(E.Kb() + ((size_t)((b * 8 + h) * SEQ + t)) * 96 + d) = pack8(v);
                    else *(v4u*)(E.Vb() + ((size_t)((b * 8 + h) * SEQ + t)) * 64 + d) = pack8(v);
                }
            }
    } break;
    case EK_Y: {
#pragma unroll
        for (int ai = 0; ai < 2; ++ai)
#pragma unroll
            for (int m = 0; m < 4; ++m) {
                const int r = rbase + ai * HALF + m * 16;
#pragma unroll
                for (int bj = 0; bj < 2; ++bj) { LOADV(v, ai, bj, m);
#pragma unroll
                    for (int j = 0; j < 8; ++j) v[j] = gelu_tanh(v[j]);
                    const int col = u.pn * 256 + bj * HALF + cw, t = col >> 4, c0 = col & 15;
                    *(v4u*)(E.YS() + ((size_t)(r * TCH + t)) * 512 + u.z * 16 + c0) = pack8(v); }
            }
    } break;
    case EK_P4: {
#pragma unroll
        for (int ai = 0; ai < 2; ++ai)
#pragma unroll
            for (int m = 0; m < 4; ++m) {
                const int r = rbase + ai * HALF + m * 16;
                if (u.z == 0) {
                    float a[8], gt[8]; LOADV(a, ai, 0, m); LOADV(gt, ai, 1, m);
                    const int col = u.pn * 128 + cw;
                    const v2u gw = *(const v2u*)(E.GATES() + (size_t)r * 2048 + col); constexpr float I255 = 1.0f / 255.0f;
                    const float gs[8] = {(float)(gw.x & 255u) * I255, (float)((gw.x >> 8) & 255u) * I255, (float)((gw.x >> 16) & 255u) * I255, (float)(gw.x >> 24) * I255,
                                         (float)(gw.y & 255u) * I255, (float)((gw.y >> 8) & 255u) * I255, (float)((gw.y >> 16) & 255u) * I255, (float)(gw.y >> 24) * I255};
#pragma unroll
                    for (int j = 0; j < 8; ++j) v[j] = a[j] * sigmoidf_(gt[j]) * gs[j];
                    *(v4u*)(E.MERGED() + (size_t)r * 1024 + col) = pack8(v);
                } else {
#pragma unroll
                    for (int bj = 0; bj < 2; ++bj) { LOADV(v, ai, bj, m); const int col = u.pn * 256 + bj * HALF + cw;
                        const v2u gw = *(const v2u*)(E.GATES() + (size_t)r * 2048 + 1024 + col); constexpr float I255 = 1.0f / 255.0f;
                        const v4u sw = *(const v4u*)(E.MERGED() + (size_t)r * 1024 + col);
                        v[0] = v[0] * ((float)(gw.x & 255u) * I255) + bf_lo(sw.x); v[1] = v[1] * ((float)((gw.x >> 8) & 255u) * I255) + bf_hi(sw.x);
                        v[2] = v[2] * ((float)((gw.x >> 16) & 255u) * I255) + bf_lo(sw.y); v[3] = v[3] * ((float)(gw.x >> 24) * I255) + bf_hi(sw.y);
                        v[4] = v[4] * ((float)(gw.y & 255u) * I255) + bf_lo(sw.z); v[5] = v[5] * ((float)((gw.y >> 8) & 255u) * I255) + bf_hi(sw.z);
                        v[6] = v[6] * ((float)((gw.y >> 16) & 255u) * I255) + bf_lo(sw.w); v[7] = v[7] * ((float)(gw.y >> 24) * I255) + bf_hi(sw.w);
                        *(v4u*)(E.MERGED() + (size_t)r * 1024 + col) = pack8(v); }
                }
            }
    } break;
    case EK_OUT: case EK_MO: {
        u64* ssq = (g.epi == EK_OUT) ? E.ssq1() : E.ssq2();
#pragma unroll
        for (int ai = 0; ai < 2; ++ai)
#pragma unroll
            for (int m = 0; m < 4; ++m) {
                const int r = rbase + ai * HALF + m * 16; float s = 0.f;
                float qs = 0.f; if (g.epi == EK_MO) qs = H8_SCALE * rsqrtf(fx_get(E.ssq1() + r) * (1.0f / 1024.0f) + EPS);
#pragma unroll
                for (int bj = 0; bj < 2; ++bj) { LOADV(v, ai, bj, m); const int col = u.pn * 256 + bj * HALF + cw;
                    if (g.epi == EK_OUT) { const f32x4 x0 = *(const f32x4*)(E.x + (size_t)r * 1024 + col), x1 = *(const f32x4*)(E.x + (size_t)r * 1024 + col + 4);
                        v[0] += x0[0]; v[1] += x0[1]; v[2] += x0[2]; v[3] += x0[3]; v[4] += x1[0]; v[5] += x1[1]; v[6] += x1[2]; v[7] += x1[3]; }
                    else { const v4u hw = *(const v4u*)(E.HB() + (size_t)r * 1024 + col);
                        v[0] += bf_lo(hw.x); v[1] += bf_hi(hw.x); v[2] += bf_lo(hw.y); v[3] += bf_hi(hw.y); v[4] += bf_lo(hw.z); v[5] += bf_hi(hw.z); v[6] += bf_lo(hw.w); v[7] += bf_hi(hw.w); }
#pragma unroll
                    for (int j = 0; j < 8; ++j) s += v[j] * v[j];
                    *(v4u*)((probe ? (bf16*)E.H() : E.HB()) + (size_t)r * 1024 + col) = pack8(v);
                    if (g.epi == EK_MO && !probe) {
                        unsigned w0 = 0u, w1 = 0u;
#pragma unroll
                        for (int j = 0; j < 4; ++j) { w0 = __builtin_amdgcn_cvt_pk_u8_f32(__builtin_amdgcn_fmed3f(__builtin_rintf(__builtin_fmaf(v[j], qs, 128.0f)), 1.0f, 255.0f), j, w0);
                                                      w1 = __builtin_amdgcn_cvt_pk_u8_f32(__builtin_amdgcn_fmed3f(__builtin_rintf(__builtin_fmaf(v[4 + j], qs, 128.0f)), 1.0f, 255.0f), j, w1); }
                        *(v2u*)(E.H8() + (size_t)r * 1024 + col) = (v2u){w0 ^ 0x80808080u, w1 ^ 0x80808080u}; } }
                s = quad_sum16(s); if (fq == 0 && !probe) fx_add(ssq + r, s);
            }
    } break;
    case EK_W1: case EK_W2: case EK_W3: {
#pragma unroll
        for (int ai = 0; ai < 2; ++ai)
#pragma unroll
            for (int m = 0; m < 4; ++m) {
                const int r = rbase + ai * HALF + m * 16;
#pragma unroll
                for (int bj = 0; bj < 2; ++bj) { LOADV(v, ai, bj, m); const int col = u.pn * 256 + bj * HALF + cw;
                    bf16* p;
                    if (g.epi == EK_W1) p = E.W1() + ((size_t)(u.z * 256 + r)) * 1024 + col;
                    else if (g.epi == EK_W2) p = E.W2() + ((size_t)((r >> 8) * 1024 + u.z * 256 + (r & 255))) * 1024 + col;
                    else p = E.W3() + ((size_t)(u.pn * 1024 + r)) * 1024 + u.z * 256 + (col & 255);
                    *(v4u*)p = pack8(v); }
            }
    } break;
    case EK_PS2: {
#pragma unroll
        for (int ai = 0; ai < 2; ++ai)
#pragma unroll
            for (int m = 0; m < 4; ++m) {
                const int r = rbase + ai * HALF + m * 16;
#pragma unroll
                for (int bj = 0; bj < 2; ++bj) { LOADV(v, ai, bj, m);
                    const v4u ow = {pkh2(v[0], v[1]), pkh2(v[2], v[3]), pkh2(v[4], v[5]), pkh2(v[6], v[7])};
                    *(v4u*)(E.SC() + (size_t)r * 2048 + u.pn * 256 + bj * HALF + cw) = ow; }
            }
    } break;
    default: break;
    }
}

__device__ __forceinline__ void epilogue_ms2(const EpiArgs& E, Acc& acc, const Unit& u, int wr, int wc, int fr, int fq, PG8_LAS float* xch) {
    const int rbase = u.pm * BM + wr * 64 + fr, cw = wc * 32 + 8 * fq;
#pragma unroll
    for (int ai = 0; ai < 2; ++ai)
#pragma unroll
        for (int m = 0; m < 4; ++m) {
            const int r = rbase + ai * HALF + m * 16;
            const float sc = rsqrtf(fx_get(E.ssq1() + r) * (1.0f / 1024.0f) + EPS) * (0.0625f * 1.4426950408889634f);
            float s = 0.f;
#pragma unroll
            for (int bj = 0; bj < 2; ++bj)
#pragma unroll
                for (int n = 0; n < 2; ++n) { f32x4 t = acc[ai][bj][m][n];
                    t[0] = __builtin_amdgcn_exp2f(fminf(t[0] * sc, 100.f)); t[1] = __builtin_amdgcn_exp2f(fminf(t[1] * sc, 100.f)); t[2] = __builtin_amdgcn_exp2f(fminf(t[2] * sc, 100.f)); t[3] = __builtin_amdgcn_exp2f(fminf(t[3] * sc, 100.f));
                    s += (t[0] + t[1]) + (t[2] + t[3]); acc[ai][bj][m][n] = t; }
            s = quad_sum16(s);
            if (fq == 0) xch[(ai * HALF + wr * 64 + m * 16 + fr) * 4 + wc] = s;
        }
    asm volatile("s_waitcnt lgkmcnt(0)" ::: "memory"); __builtin_amdgcn_s_barrier(); asm volatile("" ::: "memory");
    float v[8];
#pragma unroll
    for (int ai = 0; ai < 2; ++ai)
#pragma unroll
        for (int m = 0; m < 4; ++m) {
            const int r = rbase + ai * HALF + m * 16;
            const f32x4 ps = *(const PG8_LAS f32x4*)(xch + (ai * HALF + wr * 64 + m * 16 + fr) * 4);
            const float inv = __builtin_amdgcn_rcpf((ps[0] + ps[1]) + (ps[2] + ps[3]));
#pragma unroll
            for (int bj = 0; bj < 2; ++bj) { LOADV(v, ai, bj, m);
#pragma unroll
                for (int j = 0; j < 8; ++j) v[j] *= inv;
                *(v4u*)(E.PM() + (size_t)r * 1024 + u.pn * 256 + bj * HALF + cw) = pack8(v); }
        }
}

__device__ __forceinline__ void epilogue_sloc(const EpiArgs& E, const Acc& acc, const Unit& u, int wr, int wc, int fr, int fq) {
    const int rbase = u.pm * BM + wr * 64 + fr, cw = wc * 32 + 8 * fq, g = u.z;
    float v[8];
#pragma unroll
    for (int ai = 0; ai < 2; ++ai)
#pragma unroll
        for (int m = 0; m < 4; ++m) {
            const int r = rbase + ai * HALF + m * 16;
#pragma unroll
            for (int bj = 0; bj < 2; ++bj) { LOADV(v, ai, bj, m); float* p = E.SLOC() + ((size_t)(g * NCHUNK + r)) * 256 + bj * HALF + cw;
                *(f32x4*)p = (f32x4){v[0], v[1], v[2], v[3]}; *(f32x4*)(p + 4) = (f32x4){v[4], v[5], v[6], v[7]}; }
        }
    asm volatile("s_waitcnt vmcnt(0)" ::: "memory");
    __syncthreads();
    int tid = threadIdx.x; asm volatile("" : "+v"(tid));
    if (tid < 256) {
        const int bl = tid >> 7, dir = (tid >> 6) & 1, p = tid & 63;
        const int pi = (dir * 32 + g) * 64 + p;
        const float dt = __expf(E.log_dt[dir * 32 + g]);
        const float lr = E.lam_re[pi], li = E.lam_im[pi];
        const float mag = __expf((float)TCH * lr * dt); float sn, cs; sincos_rev((float)TCH * li * dt, sn, cs);
        const float Ar = mag * cs, Ai = mag * sn;
        const int row0 = u.pm * BM + bl * 128;
        const unsigned long long* S = (const unsigned long long*)(E.SLOC() + ((size_t)(g * NCHUNK + row0)) * 256 + dir * 128 + p * 2);
        bf16* C = E.U() + ((size_t)(g * NCHUNK + row0)) * UPITCH + 512 + dir * 128 + p * 2;
        float fr_ = 0.f, fi_ = 0.f;
        for (int n0 = 0; n0 < 128; n0 += 16) {
            unsigned long long sv[16];
#pragma unroll
            for (int k = 0; k < 16; ++k) { const int n = dir ? (127 - (n0 + k)) : (n0 + k); sv[k] = __hip_atomic_load(S + (size_t)n * 128, RLX_AGENT); }
#pragma unroll
            for (int k = 0; k < 16; ++k) { const int n = dir ? (127 - (n0 + k)) : (n0 + k);
                *(unsigned*)(C + (size_t)n * UPITCH) = pk2(fr_, fi_);
                const float sr = __builtin_bit_cast(float, (unsigned)sv[k]), si = __builtin_bit_cast(float, (unsigned)(sv[k] >> 32));
                const float nr = Ar * fr_ - Ai * fi_ + sr, ni = Ar * fi_ + Ai * fr_ + si; fr_ = nr; fi_ = ni; }
        }
    }
}

template <bool DUMMY = true>
__device__ __forceinline__ void gemm_phase(PG8_LAS unsigned char* lds, const GemmDesc& g, const EpiArgs& E, int G, int c, int mode = 0) {
    const bool dry = (mode == 1);
    int tid_ = threadIdx.x; asm volatile("" : "+v"(tid_));
    const int tid = tid_, wid = __builtin_amdgcn_readfirstlane(tid >> 6), lane = tid & 63, wr = wid >> 2, wc = wid & 3, fr = lane & 15, fq = lane >> 4;
    const int K = g.K, nt = K / BK, lda = g.lda, ldb = g.ldb;
    unsigned voffA[2], voffB[2];
#pragma unroll
    for (int i = 0; i < 2; ++i) { int R, C; stage_rc(tid * 16 + i * 8192, R, C); const int Rb = (R & ~31) + perm32(R & 31);
        voffA[i] = (unsigned)(R * lda + C) * 2u; voffB[i] = (unsigned)(Rb * ldb + C) * 2u; }
    const size_t kstep = (size_t)(BK * 2);
    const size_t hA = (size_t)HALF * lda * 2, hB = (size_t)HALF * ldb * 2;
    const unsigned ldsw = (unsigned)wid * 1024u;
    const int aoff = lds_byte(wr * 64 + fr, fq * 8), boff = lds_byte(wc * 32 + fr, fq * 8);
#define PG8_SA(b, h) (((b) * 2 + (h)) * HTB)
#define PG8_SB(b, h) ((4 + (b) * 2 + (h)) * HTB)
#define PG8_STAGE(bufoff, gbase, voff) do { _Pragma("unroll") for (int _i = 0; _i < 2; ++_i) \
        __builtin_amdgcn_global_load_lds((const unsigned*)((const char*)(gbase) + (voff)[_i]), (PG8_LAS unsigned*)(lds + (bufoff) + ldsw + _i * 8192), 16, 0, 0); } while (0)
#define PG8_LDA(dst, b, h) do { _Pragma("unroll") for (int m = 0; m < 4; ++m) _Pragma("unroll") for (int k = 0; k < 2; ++k) dst[m][k] = *(const PG8_LAS bf16x8*)(lds + PG8_SA(b, h) + aoff + m * 2048 + k * 1024); } while (0)
#define PG8_LDB(dst, b, h) do { _Pragma("unroll") for (int n = 0; n < 2; ++n) _Pragma("unroll") for (int k = 0; k < 2; ++k) dst[n][k] = *(const PG8_LAS bf16x8*)(lds + PG8_SB(b, h) + boff + n * 2048 + k * 1024); } while (0)
#define PG8_MMA(ai, bj, At, Bt) do { __builtin_amdgcn_s_setprio(1); _Pragma("unroll") for (int m = 0; m < 4; ++m) _Pragma("unroll") for (int n = 0; n < 2; ++n) _Pragma("unroll") for (int k = 0; k < 2; ++k) \
        acc[ai][bj][m][n] = __builtin_amdgcn_mfma_f32_16x16x32_bf16(Bt[n][k], At[m][k], acc[ai][bj][m][n], 0, 0, 0); __builtin_amdgcn_s_setprio(0); } while (0)
#define PG8_WAIT_V(n) asm volatile("s_waitcnt vmcnt(" #n ")" ::: "memory")
#define PG8_WAIT_L(n) asm volatile("s_waitcnt lgkmcnt(" #n ")" ::: "memory")
#define PG8_BAR __builtin_amdgcn_s_barrier()
#define PG8_SCHED __builtin_amdgcn_sched_barrier(0)
    Unit cur, nxt; int ui = 0;
    if (!g.next(0, G, c, cur)) return;
    Acc acc;
#pragma unroll
    for (int a = 0; a < 2; ++a)
#pragma unroll
        for (int b = 0; b < 2; ++b)
#pragma unroll
            for (int m = 0; m < 4; ++m)
#pragma unroll
                for (int n = 0; n < 2; ++n) acc[a][b][m][n] = (f32x4){0.f, 0.f, 0.f, 0.f};
    bf16x8 At[4][2], B0[2][2], B1[2][2];
    const char* cA = g.aptr(cur); const char* cB = g.bptr(cur);
    PG8_STAGE(PG8_SB(0, 0), cB, voffB); PG8_STAGE(PG8_SB(0, 1), cB + hB, voffB); PG8_STAGE(PG8_SA(0, 0), cA, voffA); PG8_STAGE(PG8_SA(0, 1), cA + hA, voffA);
    if (wr == 1) PG8_BAR;
    PG8_WAIT_V(2); PG8_BAR;
    PG8_STAGE(PG8_SB(1, 0), cB + kstep, voffB); PG8_STAGE(PG8_SA(1, 0), cA + kstep, voffA); PG8_STAGE(PG8_SB(1, 1), cB + hB + kstep, voffB);
    PG8_WAIT_V(6); PG8_BAR;
    for (;;) {
        const bool has_next = g.next(ui + 1, G, c, nxt);
        const char* nA = has_next ? g.aptr(nxt) : cA; const char* nB = has_next ? g.bptr(nxt) : cB;
        for (int t = 0; t < nt; t += 2) {
            const bool last = (t == nt - 2);
            const char* a1 = cA + (size_t)(t + 1) * kstep;
            const char* a2 = last ? nA : cA + (size_t)(t + 2) * kstep; const char* b2 = last ? nB : cB + (size_t)(t + 2) * kstep;
            const char* a3 = a2 + kstep; const char* b3 = b2 + kstep;
            PG8_LDB(B0, 0, 0); PG8_LDB(B1, 0, 1); PG8_SCHED; PG8_LDA(At, 0, 0); PG8_STAGE(PG8_SA(1, 1), a1 + hA, voffA);
            PG8_WAIT_V(8); PG8_WAIT_L(0); PG8_BAR; PG8_MMA(0, 0, At, B0); PG8_MMA(0, 1, At, B1); PG8_BAR; PG8_SCHED;
            PG8_LDA(At, 0, 1); PG8_STAGE(PG8_SB(0, 0), b2, voffB); PG8_STAGE(PG8_SB(0, 1), b2 + hB, voffB); PG8_STAGE(PG8_SA(0, 0), a2, voffA);
            PG8_WAIT_V(8); PG8_WAIT_L(0); PG8_BAR; PG8_MMA(1, 0, At, B0); PG8_MMA(1, 1, At, B1); PG8_BAR; PG8_SCHED;
            PG8_LDB(B0, 1, 0); PG8_LDB(B1, 1, 1); PG8_SCHED; PG8_LDA(At, 1, 0); PG8_STAGE(PG8_SA(0, 1), a2 + hA, voffA);
            PG8_WAIT_V(8); PG8_WAIT_L(0); PG8_BAR; PG8_MMA(0, 0, At, B0); PG8_MMA(0, 1, At, B1); PG8_BAR; PG8_SCHED;
            PG8_LDA(At, 1, 1); PG8_STAGE(PG8_SB(1, 0), b3, voffB); PG8_STAGE(PG8_SB(1, 1), b3 + hB, voffB); PG8_STAGE(PG8_SA(1, 0), a3, voffA);
            PG8_WAIT_V(8); PG8_WAIT_L(0); PG8_BAR; PG8_MMA(1, 0, At, B0); PG8_MMA(1, 1, At, B1); PG8_BAR; PG8_SCHED;
        }
        if (wr == 0) PG8_BAR;
        if (!g.after_drain && !dry) { if (g.epi == EK_MS2) epilogue_ms2(E, acc, cur, wr, wc, fr, fq, (PG8_LAS float*)(lds + XCH_OFF_) + (ui & 1) * 1024); else epilogue(g, E, acc, cur, wr, wc, fr, fq, mode == 2); }
        if (dry) { _Pragma("unroll") for (int a = 0; a < 2; ++a) _Pragma("unroll") for (int b = 0; b < 2; ++b) _Pragma("unroll") for (int m = 0; m < 4; ++m) _Pragma("unroll") for (int n = 0; n < 2; ++n) asm volatile("" :: "v"(acc[a][b][m][n])); }
        if (!has_next) break;
#pragma unroll
        for (int a = 0; a < 2; ++a)
#pragma unroll
            for (int b = 0; b < 2; ++b)
#pragma unroll
                for (int m = 0; m < 4; ++m)
#pragma unroll
                    for (int n = 0; n < 2; ++n) acc[a][b][m][n] = (f32x4){0.f, 0.f, 0.f, 0.f};
        cur = nxt; cA = nA; cB = nB; ++ui;
        if (wr == 1) PG8_BAR;
    }
    PG8_WAIT_V(0);
    PG8_BAR;
    if (g.after_drain && !dry) epilogue_sloc(E, acc, cur, wr, wc, fr, fq);
#undef PG8_SA
#undef PG8_SB
#undef PG8_STAGE
#undef PG8_LDA
#undef PG8_LDB
#undef PG8_MMA
#undef PG8_WAIT_V
#undef PG8_WAIT_L
#undef PG8_BAR
#undef PG8_SCHED
}
}

namespace att {
using s16x4  = __attribute__((ext_vector_type(4))) short;
using f32x16 = __attribute__((ext_vector_type(16))) float;
constexpr int DQK = 96, DV = 64, NW = 8, QBLK = 32, KVBLK = 64;
constexpr int KPITCH = DQK * 2 + 16;
constexpr int SHM_K = KVBLK * KPITCH, SHM_V = KVBLK * DV * 2;
constexpr int NBUF = 3;
constexpr int OFF_V = 0, OFF_K = NBUF * SHM_V, OFF_WS = OFF_K + NBUF * SHM_K;
constexpr float THRL = 8.0f;
#define SBAR() __builtin_amdgcn_sched_barrier(0)
__device__ __forceinline__ int crow(int r, int hi) { return (r & 3) + 8 * (r >> 2) + 4 * hi; }
__device__ __forceinline__ unsigned cvtpk(float lo, float hi) { unsigned r; asm volatile("v_cvt_pk_bf16_f32 %0, %1, %2" : "=v"(r) : "v"(lo), "v"(hi)); return r; }
__device__ __forceinline__ float max3f(float a, float b, float c) { return __builtin_fmaxf(__builtin_fmaxf(a, b), c); }
template <bool FIRST>
__device__ __forceinline__ void partialSM(f32x16& p0, f32x16& p1, float& m_reg, f32x16& negm, float& alpha) {
    float a = max3f(p0[0], p0[1], p1[0]), b = max3f(p0[2], p0[3], p1[1]); a = max3f(a, p1[2], p1[3]);
#pragma unroll
    for (int r = 4; r < 16; r += 4) { a = max3f(a, p0[r], p0[r + 1]); b = max3f(b, p0[r + 2], p0[r + 3]); a = max3f(a, p1[r], p1[r + 1]); b = max3f(b, p1[r + 2], p1[r + 3]); }
    float pmax = fmaxf(a, b);
    { auto rr = __builtin_amdgcn_permlane32_swap(__float_as_uint(pmax), __float_as_uint(pmax), false, false);
      pmax = fmaxf(__uint_as_float(rr[0]), __uint_as_float(rr[1])); }
    alpha = 1.f;
    if (FIRST || !__builtin_expect(__all(pmax <= THRL), 1)) {
        const float d = FIRST ? pmax : fmaxf(pmax, 0.f);
        m_reg += d; if (!FIRST) alpha = __builtin_amdgcn_exp2f(-d);
#pragma unroll
        for (int r = 0; r < 16; ++r) { p0[r] -= d; p1[r] -= d; }
#pragma unroll
        for (int r = 0; r < 16; ++r) negm[r] = -m_reg;
    }
#pragma unroll
    for (int r = 0; r < 16; ++r) p0[r] = __builtin_amdgcn_exp2f(p0[r]);
}
__device__ __forceinline__ void finishSM(f32x16& p0, f32x16& p1, float alpha, float& l_reg, bf16x8& pa0, bf16x8& pa1, bf16x8& pa2, bf16x8& pa3) {
#pragma unroll
    for (int r = 0; r < 16; ++r) p1[r] = __builtin_amdgcn_exp2f(p1[r]);
    float ps = 0;
#pragma unroll
    for (int r = 0; r < 16; ++r) ps += p0[r];
#pragma unroll
    for (int r = 0; r < 16; ++r) ps += p1[r];
    { auto rr = __builtin_amdgcn_permlane32_swap(__float_as_uint(ps), __float_as_uint(ps), false, false);
      ps = __uint_as_float(rr[0]) + __uint_as_float(rr[1]); }
    l_reg = l_reg * alpha + ps;
#define PK4(P, BASE, OUT) do { unsigned a0 = cvtpk(P[BASE + 0], P[BASE + 1]), a1 = cvtpk(P[BASE + 2], P[BASE + 3]);   \
    unsigned b0 = cvtpk(P[BASE + 4], P[BASE + 5]), b1 = cvtpk(P[BASE + 6], P[BASE + 7]);                              \
    auto r0 = __builtin_amdgcn_permlane32_swap(a0, b0, false, false); auto r1 = __builtin_amdgcn_permlane32_swap(a1, b1, false, false); \
    v4u w = {r0[0], r1[0], r0[1], r1[1]}; OUT = *reinterpret_cast<bf16x8*>(&w); } while (0)
    PK4(p0, 0, pa0); PK4(p0, 8, pa1); PK4(p1, 0, pa2); PK4(p1, 8, pa3);
#undef PK4
}
__device__ __forceinline__ void qkt(f32x16& p0, f32x16& p1, const char* Ks, const bf16x8* qr, const f32x16& negm, int r32, int hi) {
#pragma unroll
    for (int d0 = 0; d0 < DQK / 16; ++d0) { const int cb = (d0 * 16 + hi * 8) * 2;
        const bf16x8 b0 = *reinterpret_cast<const bf16x8*>(Ks + r32 * KPITCH + cb);
        const bf16x8 b1 = *reinterpret_cast<const bf16x8*>(Ks + (32 + r32) * KPITCH + cb);
        if (d0 == 0) { p0 = __builtin_amdgcn_mfma_f32_32x32x16_bf16(b0, qr[0], negm, 0, 0, 0); p1 = __builtin_amdgcn_mfma_f32_32x32x16_bf16(b1, qr[0], negm, 0, 0, 0); }
        else { p0 = __builtin_amdgcn_mfma_f32_32x32x16_bf16(b0, qr[d0], p0, 0, 0, 0); p1 = __builtin_amdgcn_mfma_f32_32x32x16_bf16(b1, qr[d0], p1, 0, 0, 0); } }
}
__device__ __forceinline__ int v_st(int k, int c) { const int kk = (k & ~0xC) | ((k & 4) << 1) | ((k & 8) >> 1); return ((kk >> 3) * 2 + (c >> 5)) * 512 + ((kk & 7) * 32 + (c & 31)) * 2; }
__device__ __forceinline__ int v_rd_base(int lane) { return ((lane & 3) << 3) | (((lane >> 2) & 3) << 6) | (((lane >> 4) & 1) << 5) | (((lane >> 5) & 1) << 8); }
constexpr int v_rd_off(int d0, int ks, int half) { return d0 * 512 + ks * 2048 + half * 1024; }
template <int OFF> __device__ __forceinline__ s16x4 tr_read(int vb) {
    s16x4 r; asm volatile("ds_read_b64_tr_b16 %0, %1 offset:%2" : "=&v"(r) : "v"(vb), "i"(OFF) : "memory"); return r;
}
template <int D0> __device__ __forceinline__ void pv_one(f32x16& od, int vb, bf16x8 pa0, bf16x8 pa1, bf16x8 pa2, bf16x8 pa3) {
    const s16x4 l0 = tr_read<v_rd_off(D0, 0, 0)>(vb), h0 = tr_read<v_rd_off(D0, 0, 1)>(vb), l1 = tr_read<v_rd_off(D0, 1, 0)>(vb), h1 = tr_read<v_rd_off(D0, 1, 1)>(vb);
    const s16x4 l2 = tr_read<v_rd_off(D0, 2, 0)>(vb), h2 = tr_read<v_rd_off(D0, 2, 1)>(vb), l3 = tr_read<v_rd_off(D0, 3, 0)>(vb), h3 = tr_read<v_rd_off(D0, 3, 1)>(vb);
    asm volatile("s_waitcnt lgkmcnt(0)" ::: "memory"); SBAR();
#define PK(L, H) (bf16x8){L[0], L[1], L[2], L[3], H[0], H[1], H[2], H[3]}
    od = __builtin_amdgcn_mfma_f32_32x32x16_bf16(pa0, PK(l0, h0), od, 0, 0, 0);
    od = __builtin_amdgcn_mfma_f32_32x32x16_bf16(pa1, PK(l1, h1), od, 0, 0, 0);
    od = __builtin_amdgcn_mfma_f32_32x32x16_bf16(pa2, PK(l2, h2), od, 0, 0, 0);
    od = __builtin_amdgcn_mfma_f32_32x32x16_bf16(pa3, PK(l3, h3), od, 0, 0, 0);
#undef PK
}
__device__ __forceinline__ void pv_d0(f32x16* o, int vb, bf16x8 pa0, bf16x8 pa1, bf16x8 pa2, bf16x8 pa3) {
    pv_one<0>(o[0], vb, pa0, pa1, pa2, pa3); pv_one<1>(o[1], vb, pa0, pa1, pa2, pa3);
}
__device__ __forceinline__ void attn_unit(const bf16* __restrict__ Qb, const bf16* __restrict__ Kh, const bf16* __restrict__ Vh, bf16* __restrict__ Ob, char* lds) {
    int tid_ = threadIdx.x; asm volatile("" : "+v"(tid_));
    const int tid = tid_, wid = tid >> 6, lane = tid & 63, r32 = lane & 31, hi = lane >> 5;
    char* V_lds = lds + OFF_V; char* K_lds = lds + OFF_K;
    float* ws = (float*)(lds + OFF_WS) + wid * 64; float* li_l = ws; float* al_l = ws + 32;
    float m_reg = 0.f, l_reg = 0; f32x16 o[2] = {}; bf16x8 qr[DQK / 16]; f32x16 negm = {};
    const bf16* Qw = Qb + (long)(wid * QBLK + r32) * DQK + hi * 8;
#pragma unroll
    for (int d0 = 0; d0 < DQK / 16; ++d0) qr[d0] = *reinterpret_cast<const bf16x8*>(Qw + d0 * 16);
    const int kc0 = tid, kc1 = 512 + (tid & 255);
    const int kd0 = (kc0 / 12) * KPITCH + (kc0 % 12) * 16, kd1 = (kc1 / 12) * KPITCH + (kc1 % 12) * 16;
    const int vd0 = v_st(tid >> 3, (tid & 7) * 8);
    const int vb0 = (int)(uintptr_t)V_lds + v_rd_base(lane);
    const bool k1w = (__builtin_amdgcn_readfirstlane(tid) < 256);
    struct { bf16x8 vs0, ks0, ks1; } sr_[2];
#define SLOAD(i, k0) do { const char* kb_ = (const char*)(Kh + (long)(k0) * DQK); const char* vb_ = (const char*)(Vh + (long)(k0) * DV); \
    sr_[i].vs0 = *reinterpret_cast<const bf16x8*>(vb_ + tid * 16); sr_[i].ks0 = *reinterpret_cast<const bf16x8*>(kb_ + kc0 * 16); sr_[i].ks1 = *reinterpret_cast<const bf16x8*>(kb_ + kc1 * 16); } while (0)
#define SWRITE(slot, i) do { *(bf16x8*)(V_lds + (slot) * SHM_V + vd0) = sr_[i].vs0; *(bf16x8*)(K_lds + (slot) * SHM_K + kd0) = sr_[i].ks0; \
    if (k1w) *(bf16x8*)(K_lds + (slot) * SHM_K + kd1) = sr_[i].ks1; } while (0)
#define RESC(a) do { if (__any((a) < 1.f)) { if (hi == 0) al_l[r32] = (a); asm volatile("s_waitcnt lgkmcnt(0)" ::: "memory"); \
    _Pragma("unroll") for (int d = 0; d < 2; ++d) _Pragma("unroll") for (int r = 0; r < 16; ++r) o[d][r] *= al_l[crow(r, hi)]; } } while (0)
#define NEXT3(s) ((s) == 2 ? 0 : (s) + 1)
    f32x16 pA0, pA1, pB0, pB1; float alA, alB; bf16x8 pa0, pa1, pa2, pa3; constexpr int NT = SEQ / KVBLK;
    SLOAD(0, 0); asm volatile("s_waitcnt vmcnt(0)" ::: "memory"); SWRITE(0, 0);
    SLOAD(1, KVBLK); SLOAD(0, 2 * KVBLK);
    __syncthreads();
    qkt(pA0, pA1, K_lds, qr, negm, r32, hi); partialSM<true>(pA0, pA1, m_reg, negm, alA);
    SWRITE(1, 1);
    __syncthreads();
    int sk = 1, sv = 0;
    for (int j = 1; j + 1 < NT; j += 2) {
        SBAR(); qkt(pB0, pB1, K_lds + sk * SHM_K, qr, negm, r32, hi);
        finishSM(pA0, pA1, alA, l_reg, pa0, pa1, pa2, pa3); SBAR();
        SLOAD(1, (j + 2) * KVBLK); SBAR();
        pv_d0(o, vb0 + sv * SHM_V, pa0, pa1, pa2, pa3); partialSM<false>(pB0, pB1, m_reg, negm, alB);
        { const int sw = NEXT3(sk); SWRITE(sw, 0); }
        RESC(alB); __syncthreads();
        sv = sk; sk = NEXT3(sk);
        SBAR(); qkt(pA0, pA1, K_lds + sk * SHM_K, qr, negm, r32, hi);
        finishSM(pB0, pB1, alB, l_reg, pa0, pa1, pa2, pa3); SBAR();
        SLOAD(0, (j + 3 < NT ? j + 3 : NT - 1) * KVBLK); SBAR();
        pv_d0(o, vb0 + sv * SHM_V, pa0, pa1, pa2, pa3); partialSM<false>(pA0, pA1, m_reg, negm, alA);
        { const int sw = NEXT3(sk); SWRITE(sw, 1); }
        RESC(alA); __syncthreads();
        sv = sk; sk = NEXT3(sk);
    }
    SBAR(); qkt(pB0, pB1, K_lds + sk * SHM_K, qr, negm, r32, hi);
    finishSM(pA0, pA1, alA, l_reg, pa0, pa1, pa2, pa3); SBAR();
    pv_d0(o, vb0 + sv * SHM_V, pa0, pa1, pa2, pa3); partialSM<false>(pB0, pB1, m_reg, negm, alB);
    RESC(alB);
    finishSM(pB0, pB1, alB, l_reg, pa0, pa1, pa2, pa3); SBAR();
    pv_d0(o, vb0 + sk * SHM_V, pa0, pa1, pa2, pa3);
    if (hi == 0) li_l[r32] = l_reg; asm volatile("s_waitcnt lgkmcnt(0)" ::: "memory");
    float rli[16];
#pragma unroll
    for (int r = 0; r < 16; ++r) rli[r] = __builtin_amdgcn_rcpf(li_l[crow(r, hi)]);
    bf16* Ow = Ob + (long)(wid * QBLK) * 512;
#pragma unroll
    for (int r = 0; r < 16; ++r) { const int orow = crow(r, hi);
#pragma unroll
        for (int d0 = 0; d0 < 2; ++d0) Ow[(long)orow * 512 + d0 * 32 + r32] = (bf16)f2bf(o[d0][r] * rli[r]); }
    __syncthreads();
#undef SLOAD
#undef SWRITE
#undef RESC
#undef NEXT3
}
#undef SBAR
}

struct Args { const void* in[32]; float* out; unsigned char* ws; };

__device__ __forceinline__ int dst_row(int code, int n) {
    switch (code) {
    case 1: return n < 896 ? n : (n < 1152 ? 1024 + n - 896 : (n < 1184 ? 896 + n - 1152 : 1280 + n - 1184));
    case 2: { const int sel = n >> 10, j = n & 1023; return 256 * (j >> 7) + 128 * sel + (j & 127); }
    case 3: { const int h = n / 96, e = n % 96; return e < 64 ? h * 64 + e : 512 + h * 32 + e - 64; }
    case 4: { const int h = n >> 7, e = n & 127; return e < 64 ? h * 64 + e : 512 + h * 64 + e - 64; }
    default: return n;
    }
}
__device__ __forceinline__ void transpose_item(const float* W, int K, int N, bf16* WT, int code, const float* gs, LAS float* scr, int item, int lane) {
    const int nblk = N / 32, kb = item / nblk, nb = item % nblk, k0 = 64 * kb, n0 = 32 * nb;
#pragma unroll 16
    for (int i = 0; i < 32; ++i) { const int kk = 2 * i + (lane >> 5); float w = W[(size_t)(k0 + kk) * N + n0 + (lane & 31)]; if (gs) w *= gs[k0 + kk]; scr[kk * 33 + (lane & 31)] = w; }
    LDS_WAIT(); asm volatile("" ::: "memory");
    const int c = lane & 7; const int r0 = dst_row(code, n0);
#pragma unroll
    for (int j = 0; j < 4; ++j) { const int n = (lane >> 3) + 8 * j; const LAS float* s = scr + (8 * c) * 33 + n;
        v4u o; o.x = pk2(s[0 * 33], s[1 * 33]); o.y = pk2(s[2 * 33], s[3 * 33]); o.z = pk2(s[4 * 33], s[5 * 33]); o.w = pk2(s[6 * 33], s[7 * 33]);
        *(GAS v4u*)(WT + (size_t)(r0 + n) * K + k0 + 8 * c) = o; }
    LDS_WAIT(); asm volatile("" ::: "memory");
}
__device__ __forceinline__ void rms_rows2_to_bf16(const float* xrow0, const float* xrow1, const float* gain, bf16* orow0, bf16* orow1, int lane) {
    const f32x4* xa = (const f32x4*)xrow0 + lane; const f32x4* xb = (const f32x4*)xrow1 + lane; const f32x4* gr = (const f32x4*)gain + lane;
    f32x4 v[4], w[4]; float s = 0.f, t = 0.f;
#pragma unroll
    for (int j = 0; j < 4; ++j) { v[j] = xa[64 * j]; w[j] = xb[64 * j]; }
#pragma unroll
    for (int j = 0; j < 4; ++j) { s += (v[j].x * v[j].x + v[j].y * v[j].y) + (v[j].z * v[j].z + v[j].w * v[j].w); t += (w[j].x * w[j].x + w[j].y * w[j].y) + (w[j].z * w[j].z + w[j].w * w[j].w); }
#pragma unroll
    for (int o = 1; o < 64; o <<= 1) { s += __shfl_xor(s, o); t += __shfl_xor(t, o); }
    const float ra = rsqrtf(s * (1.f / 1024.f) + EPS), rb = rsqrtf(t * (1.f / 1024.f) + EPS);
    unsigned long long* oa = (unsigned long long*)orow0 + lane; unsigned long long* ob = (unsigned long long*)orow1 + lane;
#pragma unroll
    for (int j = 0; j < 4; ++j) { const f32x4 gg = gr[64 * j];
        oa[64 * j] = (unsigned long long)pk2(v[j].x * ra * gg.x, v[j].y * ra * gg.y) | ((unsigned long long)pk2(v[j].z * ra * gg.z, v[j].w * ra * gg.w) << 32);
        ob[64 * j] = (unsigned long long)pk2(w[j].x * rb * gg.x, w[j].y * rb * gg.y) | ((unsigned long long)pk2(w[j].z * rb * gg.z, w[j].w * rb * gg.w) << 32); }
}
__device__ __forceinline__ void rms_row_to_f32(const float* xrow, const float* gain, float* orow, int lane) {
    const f32x4* xr = (const f32x4*)xrow + lane; const f32x4* gr = (const f32x4*)gain + lane;
    f32x4 v[4]; float s = 0.f;
#pragma unroll
    for (int j = 0; j < 4; ++j) { v[j] = xr[64 * j]; s += (v[j].x * v[j].x + v[j].y * v[j].y) + (v[j].z * v[j].z + v[j].w * v[j].w); }
    const float rstd = rsqrtf(wave_sum(s) * (1.f / 1024.f) + EPS);
    f32x4* o = (f32x4*)orow + lane;
#pragma unroll
    for (int j = 0; j < 4; ++j) { const f32x4 gg = gr[64 * j]; o[64 * j] = (f32x4){v[j].x * rstd * gg.x, v[j].y * rstd * gg.y, v[j].z * rstd * gg.z, v[j].w * rstd * gg.w}; }
}

struct SsmP { const float *lam_re, *lam_im, *log_dt, *b_re, *b_im, *c_re, *c_im, *dsk; };
__device__ __forceinline__ void ssm_pow(const SsmP& P, int dir, int g, int p, float e, float& pr, float& pi_) {
    const int ix = (dir * 32 + g) * 64 + p; const float dt = __expf(P.log_dt[dir * 32 + g]);
    const float mag = __expf(e * P.lam_re[ix] * dt); float sn, cs; sincos_rev(e * P.lam_im[ix] * dt, sn, cs); pr = mag * cs; pi_ = mag * sn;
}
__device__ __forceinline__ void ssm_fbar(const SsmP& P, int dir, int g, int p, float& fr, float& fi) {
    const int ix = (dir * 32 + g) * 64 + p; float ar, ai; ssm_pow(P, dir, g, p, 1.0f, ar, ai);
    const float lr = P.lam_re[ix], li = P.lam_im[ix], nr = ar - 1.0f, den = lr * lr + li * li;
    fr = (nr * lr + ai * li) / den; fi = (ai * lr - nr * li) / den;
}
__device__ __forceinline__ void ssm_lag_item(const SsmP& P, bf16* MF, int g, int j, LAS float* scr, int lane) {
    float acc4[4] = {0.f, 0.f, 0.f, 0.f};
    const int c = lane >> 2, cp0 = (lane & 3) * 4;
    for (int dir = 0; dir < 2; ++dir) {
        if ((dir == 0 && j < 0) || (dir == 1 && j > 0)) continue;
        const int p = lane; float pr, pi_, fr, fi; ssm_pow(P, dir, g, p, (float)(j < 0 ? -j : j), pr, pi_); ssm_fbar(P, dir, g, p, fr, fi);
        const float wr_ = pr * fr - pi_ * fi, wi_ = pr * fi + pi_ * fr;
        const float* br = P.b_re + ((size_t)((dir * 32 + g) * 64 + p)) * 16; const float* bi = P.b_im + ((size_t)((dir * 32 + g) * 64 + p)) * 16;
#pragma unroll
        for (int q = 0; q < 16; ++q) { const float zr = wr_ * br[q] - wi_ * bi[q], zi = wr_ * bi[q] + wi_ * br[q]; scr[(p * 16 + q) * 2] = zr; scr[(p * 16 + q) * 2 + 1] = zi; }
        LDS_WAIT(); asm volatile("" ::: "memory");
        const float* cr = P.c_re + ((size_t)((dir * 32 + g) * 16 + c)) * 64; const float* ci = P.c_im + ((size_t)((dir * 32 + g) * 16 + c)) * 64;
        for (int pp = 0; pp < 64; ++pp) { const float a = cr[pp], b = ci[pp];
#pragma unroll
            for (int q = 0; q < 4; ++q) acc4[q] += a * scr[(pp * 16 + cp0 + q) * 2] - b * scr[(pp * 16 + cp0 + q) * 2 + 1]; }
        LDS_WAIT(); asm volatile("" ::: "memory");
    }
    if (j == 0) {
#pragma unroll
        for (int q = 0; q < 4; ++q) if (cp0 + q == c) acc4[q] += P.dsk[g * 16 + c];
    }
    const v2u w = {pk2(acc4[0], acc4[1]), pk2(acc4[2], acc4[3])};
    const int tlo = j > 0 ? j : 0, thi = j < 0 ? 31 + j : 31;
    for (int t = tlo; t <= thi; ++t) *(v2u*)(MF + ((size_t)(g * 512 + t * 16 + c)) * UPITCH + (t - j) * 16 + cp0) = w;
}
__device__ __forceinline__ void ssm_out_item(const SsmP& P, bf16* MF, int g, int t, int lane) {
    const int p = lane;
    for (int dir = 0; dir < 2; ++dir) {
        float pr, pi_; ssm_pow(P, dir, g, p, dir == 0 ? (float)(t + 1) : (float)(TCH - t), pr, pi_);
        for (int c = 0; c < 16; ++c) { const size_t ci = ((size_t)((dir * 32 + g) * 16 + c)) * 64 + p; const float cr = P.c_re[ci], cim = P.c_im[ci];
            const float zr = cr * pr - cim * pi_, zi = cr * pi_ + cim * pr;
            *(unsigned*)(MF + ((size_t)(g * 512 + t * 16 + c)) * UPITCH + 512 + dir * 128 + p * 2) = pk2(zr, -zi); }
    }
}
__device__ __forceinline__ void ssm_st_item(const SsmP& P, bf16* WST, int g, int dir, int p, int lane) {
    const int tp = lane >> 1, c0 = (lane & 1) * 8;
    float pr, pi_, fr, fi; ssm_pow(P, dir, g, p, dir == 0 ? (float)(TCH - 1 - tp) : (float)tp, pr, pi_); ssm_fbar(P, dir, g, p, fr, fi);
    const float wr_ = pr * fr - pi_ * fi, wi_ = pr * fi + pi_ * fr;
    const float* br = P.b_re + ((size_t)((dir * 32 + g) * 64 + p)) * 16 + c0; const float* bi = P.b_im + ((size_t)((dir * 32 + g) * 64 + p)) * 16 + c0;
    float zr[8], zi[8];
#pragma unroll
    for (int q = 0; q < 8; ++q) { zr[q] = wr_ * br[q] - wi_ * bi[q]; zi[q] = wr_ * bi[q] + wi_ * br[q]; }
    bf16* row = WST + ((size_t)(g * 256 + dir * 128 + p * 2)) * 512 + tp * 16 + c0;
    *(v4u*)row = pg8::pack8(zr); *(v4u*)(row + 512) = pg8::pack8(zi);
}

#define INS16(t, x) do { float x_ = (x); _Pragma("unroll") for (int i_ = 0; i_ < 16; ++i_) { const float a_ = fmaxf(t[i_], x_); x_ = fminf(t[i_], x_); t[i_] = a_; } } while (0)
#define CE_DESC(x, y) do { const float hi_ = fmaxf(x, y), lo_ = fminf(x, y); x = hi_; y = lo_; } while (0)
__device__ __forceinline__ void sort16_desc(float (&a)[16]) {
#pragma unroll
    for (int k = 2; k <= 16; k <<= 1)
#pragma unroll
        for (int j = k >> 1; j > 0; j >>= 1)
#pragma unroll
            for (int i = 0; i < 16; ++i) { const int l = i ^ j; if (l > i) { if ((i & k) == 0) CE_DESC(a[i], a[l]); else CE_DESC(a[l], a[i]); } }
}
__device__ __forceinline__ void merge16_desc(float (&t)[16], const float (&a)[16]) {
#pragma unroll
    for (int i = 0; i < 16; ++i) t[i] = fmaxf(t[i], a[15 - i]);
#pragma unroll
    for (int j = 8; j > 0; j >>= 1)
#pragma unroll
        for (int i = 0; i < 16; ++i) { const int l = i ^ j; if (l > i) CE_DESC(t[i], t[l]); }
}
__device__ __forceinline__ float packf(float v, unsigned code, unsigned mask) { return __builtin_bit_cast(float, (__builtin_bit_cast(unsigned, v) & ~mask) | code); }
__device__ __forceinline__ unsigned fp8x4(float a, float b, float c, float d) { int t = __builtin_amdgcn_cvt_pk_fp8_f32(a, b, 0, false); t = __builtin_amdgcn_cvt_pk_fp8_f32(c, d, t, true); return (unsigned)t; }
#define DEC8(w, lo, hi) do { lo = __builtin_amdgcn_cvt_pk_f32_fp8((int)(w), false); hi = __builtin_amdgcn_cvt_pk_f32_fp8((int)(w), true); } while (0)

__device__ __forceinline__ void peer_topk(unsigned char* ws, LAS unsigned char* ldsw, int gw, int NGW, int lane_) {
    int lane = lane_; asm volatile("" : "+v"(lane));
    const _Float16* SC = (const _Float16*)(ws + WS_SC);
    unsigned* SELI = (unsigned*)(ws + WS_SELI); float* SELW = (float*)(ws + WS_SELG);
    LAS unsigned* idxb = (LAS unsigned*)ldsw;
    v4u pf[16];
    if (gw < NTOK / 4) { const v4u* gp = (const v4u*)(SC + (size_t)gw * 4 * 2048) + lane;
#pragma unroll
        for (int b = 0; b < 16; ++b) pf[b] = gp[b * 64]; }
    for (int grp = gw; grp < NTOK / 4; grp += NGW) {
        const int tok0 = grp * 4;
#pragma unroll
        for (int b = 0; b < 16; ++b) { const int list = b * 4 + (lane >> 4), c = lane & 15; *(LAS v4u*)(ldsw + list * 256 + ((c ^ (list & 15)) << 4)) = pf[b]; }
        LDS_WAIT(); asm volatile("" ::: "memory");
        if (grp + NGW < NTOK / 4) { const v4u* gp = (const v4u*)(SC + (size_t)(grp + NGW) * 4 * 2048) + lane;
#pragma unroll
            for (int b = 0; b < 16; ++b) pf[b] = gp[b * 64]; }
        float t[16];
#pragma unroll
        for (int g = 0; g < 8; ++g) {
            float a[16];
#pragma unroll
            for (int hf = 0; hf < 2; ++hf) { const int i = g * 2 + hf; const v4u w = *(const LAS v4u*)(ldsw + lane * 256 + ((i ^ (lane & 15)) << 4));
                const unsigned ww[4] = {w.x, w.y, w.z, w.w};
#pragma unroll
                for (int q = 0; q < 4; ++q) { const h2_t h2 = __builtin_bit_cast(h2_t, ww[q]); const unsigned k = (unsigned)(i * 8 + q * 2);
                    a[hf * 8 + q * 2] = packf((float)h2.x, k, 127u); a[hf * 8 + q * 2 + 1] = packf((float)h2.y, k + 1, 127u); } }
            sort16_desc(a);
            if (g == 0) {
#pragma unroll
                for (int i = 0; i < 16; ++i) t[i] = a[i];
            } else merge16_desc(t, a);
        }
        LDS_WAIT(); asm volatile("" ::: "memory");
        { unsigned w0 = 0, w1 = 0, w2 = 0, w3 = 0;
#pragma unroll
          for (int i = 0; i < 4; ++i) { w0 |= (__builtin_bit_cast(unsigned, t[i]) & 127u) << (8 * i); w1 |= (__builtin_bit_cast(unsigned, t[4 + i]) & 127u) << (8 * i);
                                        w2 |= (__builtin_bit_cast(unsigned, t[8 + i]) & 127u) << (8 * i); w3 |= (__builtin_bit_cast(unsigned, t[12 + i]) & 127u) << (8 * i); }
          idxb[lane * 4 + 0] = w0; idxb[lane * 4 + 1] = w1; idxb[lane * 4 + 2] = w2; idxb[lane * 4 + 3] = w3; }
        float s2[16];
#pragma unroll
        for (int i = 0; i < 16; ++i) { t[i] = packf(t[i], 0u, 127u); s2[i] = __shfl_xor(t[i], 1); }
        float cd[16], cb[16], cc_[16], cx[2];
        { int n = 0;
#pragma unroll
          for (int a = 0; a < 16; ++a)
#pragma unroll
            for (int b = 0; b < 16; ++b) if ((a + 1) * (b + 1) <= 16) { const float v_ = packf(t[a] + s2[b], (unsigned)(a * 16 + b), 255u);
                if (n < 16) cd[n] = v_; else if (n < 32) cb[n - 16] = v_; else if (n < 48) cc_[n - 32] = v_; else cx[n - 48] = v_;
                ++n; } }
        sort16_desc(cd); sort16_desc(cb); sort16_desc(cc_);
        merge16_desc(cd, cb); merge16_desc(cd, cc_);
        INS16(cd, cx[0]); INS16(cd, cx[1]);
        LDS_WAIT(); asm volatile("" ::: "memory");
        if ((lane & 1) == 0) {
            const int tl_ = lane >> 4; const float rs = rsqrtf(fx_get((const u64*)(ws + WS_SSQ2) + tok0 + tl_) * (1.0f / 1024.0f) + EPS) * 1.4426950408889634f;
            const float m = packf(cd[0], 0u, 255u); float e[16], sum = 0.f;
#pragma unroll
            for (int i = 0; i < 16; ++i) { e[i] = __builtin_amdgcn_exp2f((packf(cd[i], 0u, 255u) - m) * rs); sum += e[i]; }
            const float inv = 1.0f / sum;
            const int tl = lane >> 4, head = (lane >> 1) & 7;
            const LAS unsigned char* ib = (const LAS unsigned char*)idxb;
            unsigned ids[16];
#pragma unroll
            for (int i = 0; i < 16; ++i) { const unsigned code = __builtin_bit_cast(unsigned, cd[i]) & 255u, a = code >> 4, b = code & 15u;
                ids[i] = (unsigned)ib[lane * 16 + a] * 128u + (unsigned)ib[(lane + 1) * 16 + b]; e[i] *= inv; }
            v4u* pi = (v4u*)((unsigned short*)SELI + (size_t)(tok0 + tl) * 128 + head * 16); f32x4* pw = (f32x4*)(SELW + (size_t)(tok0 + tl) * 128 + head * 16);
            pi[0] = (v4u){ids[0] | (ids[1] << 16), ids[2] | (ids[3] << 16), ids[4] | (ids[5] << 16), ids[6] | (ids[7] << 16)};
            pi[1] = (v4u){ids[8] | (ids[9] << 16), ids[10] | (ids[11] << 16), ids[12] | (ids[13] << 16), ids[14] | (ids[15] << 16)};
#pragma unroll
            for (int i = 0; i < 4; ++i) pw[i] = (f32x4){e[4 * i], e[4 * i + 1], e[4 * i + 2], e[4 * i + 3]};
        }
        LDS_WAIT(); asm volatile("" ::: "memory");
    }
}

#define TR16(acc, o0, o1, M2, M1, M0) do { float r8_[8], r4_[4]; \
    { const bool up_ = (lane & (M2)) != 0; _Pragma("unroll") for (int i_ = 0; i_ < 8; ++i_) { const float s_ = up_ ? acc[i_] : acc[8 + i_]; const float k_ = up_ ? acc[8 + i_] : acc[i_]; r8_[i_] = k_ + __shfl_xor(s_, (M2)); } } \
    { const bool up_ = (lane & (M1)) != 0; _Pragma("unroll") for (int i_ = 0; i_ < 4; ++i_) { const float s_ = up_ ? r8_[i_] : r8_[4 + i_]; const float k_ = up_ ? r8_[4 + i_] : r8_[i_]; r4_[i_] = k_ + __shfl_xor(s_, (M1)); } } \
    { const bool up_ = (lane & (M0)) != 0; const float s0_ = up_ ? r4_[0] : r4_[2], k0_ = up_ ? r4_[2] : r4_[0], s1_ = up_ ? r4_[1] : r4_[3], k1_ = up_ ? r4_[3] : r4_[1]; \
      o0 = k0_ + __shfl_xor(s0_, (M0)); o1 = k1_ + __shfl_xor(s1_, (M0)); } } while (0)

#define XSUM32(a, b) ({ const auto r_ = __builtin_amdgcn_permlane32_swap((unsigned)(a), (unsigned)(b), false, false); (int)(r_[0] + r_[1]); })
#define XSUM16(a, b) ({ const auto r_ = __builtin_amdgcn_permlane16_swap((unsigned)(a), (unsigned)(b), false, false); (int)(r_[0] + r_[1]); })
#define ROR8(v) __builtin_amdgcn_update_dpp(0, (int)(v), 0x128, 0xf, 0xf, false)

#define STAGE() __builtin_amdgcn_sched_barrier(0)
#define VINIT(x, y) asm volatile("v_mov_b32 %0, %1" : "=v"(x) : "v"(y))
__device__ __forceinline__ void u4_token(const v4u (&R)[16], const v4u (&xc)[2], int lane, float* dst) {
#define SD4(a, b, c) __builtin_amdgcn_sdot4((int)(a), (int)(b), (c), false)
    const unsigned X[8] = {xc[0].x, xc[0].y, xc[0].z, xc[0].w, xc[1].x, xc[1].y, xc[1].z, xc[1].w};
    int sl_ = SD4(X[0], 0x01010101, 0), sl2_ = SD4(X[2], 0x01010101, 0), sh_ = SD4(X[1], 0x01010101, 0), sh2_ = SD4(X[3], 0x01010101, 0);
    STAGE();
    sl_ = SD4(X[4], 0x01010101, sl_); sl2_ = SD4(X[6], 0x01010101, sl2_); sh_ = SD4(X[5], 0x01010101, sh_); sh2_ = SD4(X[7], 0x01010101, sh2_);
    STAGE();
    const int c0 = 8 * (sh_ + sh2_) - 120 * (sl_ + sl2_), zero_ = 0;
    int acc[16];
#pragma unroll
    for (int g = 0; g < 4; ++g) {
        unsigned aL[4][4], aH[4][4]; int lo[4], hi[4];
#pragma unroll
        for (int r = 0; r < 4; ++r) { const v4u w_ = R[4 * g + r]; const unsigned ww[4] = {w_.x, w_.y, w_.z, w_.w};
#pragma unroll
            for (int d = 0; d < 4; ++d) { aL[r][d] = ww[d] & 0x0F0F0F0Fu; aH[r][d] = ww[d] & 0xF0F0F0F0u; }
            VINIT(lo[r], zero_); VINIT(hi[r], c0); }
        STAGE();
#pragma unroll
        for (int r = 0; r < 4; ++r) { lo[r] = SD4(aL[r][0], X[0], lo[r]); hi[r] = SD4(aH[r][0], X[1], hi[r]); }
        STAGE();
#pragma unroll
        for (int r = 0; r < 4; ++r) { lo[r] = SD4(aL[r][1], X[2], lo[r]); hi[r] = SD4(aH[r][1], X[3], hi[r]); }
        STAGE();
#pragma unroll
        for (int r = 0; r < 4; ++r) { lo[r] = SD4(aL[r][2], X[4], lo[r]); hi[r] = SD4(aH[r][2], X[5], hi[r]); }
        STAGE();
#pragma unroll
        for (int r = 0; r < 4; ++r) { lo[r] = SD4(aL[r][3], X[6], lo[r]); hi[r] = SD4(aH[r][3], X[7], hi[r]); }
        STAGE();
#pragma unroll
        for (int r = 0; r < 4; ++r) acc[4 * g + r] = (lo[r] << 4) + hi[r];
    }
#undef SD4
    STAGE();
    int k8[8], s8[8], r8[8], k4[4], s4[4], r4[4], o0, o1;
    { const bool up_ = (lane & 1) != 0;
#pragma unroll
      for (int i = 0; i < 8; ++i) { k8[i] = up_ ? acc[8 + i] : acc[i]; s8[i] = up_ ? acc[i] : acc[8 + i]; } }
    STAGE();
#pragma unroll
    for (int i = 0; i < 8; ++i) r8[i] = k8[i] + __builtin_amdgcn_update_dpp(0, s8[i], 0xB1, 0xf, 0xf, false);
    STAGE();
    { const bool up_ = (lane & 2) != 0;
#pragma unroll
      for (int i = 0; i < 4; ++i) { k4[i] = up_ ? r8[4 + i] : r8[i]; s4[i] = up_ ? r8[i] : r8[4 + i]; } }
    STAGE();
#pragma unroll
    for (int i = 0; i < 4; ++i) r4[i] = k4[i] + __builtin_amdgcn_update_dpp(0, s4[i], 0x4E, 0xf, 0xf, false);
    STAGE();
    { const bool up_ = (lane & 4) != 0; const int s0_ = up_ ? r4[0] : r4[2], s1_ = up_ ? r4[1] : r4[3], k0_ = up_ ? r4[2] : r4[0], k1_ = up_ ? r4[3] : r4[1];
      int x0_ = __builtin_amdgcn_update_dpp(0, s0_, 0x104, 0xf, 0x5, false); int x1_ = __builtin_amdgcn_update_dpp(0, s1_, 0x104, 0xf, 0x5, false);
      x0_ = __builtin_amdgcn_update_dpp(x0_, s0_, 0x114, 0xf, 0xA, false); x1_ = __builtin_amdgcn_update_dpp(x1_, s1_, 0x114, 0xf, 0xA, false);
      o0 = k0_ + x0_; o1 = k1_ + x1_; }
    const int cc = (lane & 1) * 8 + ((lane >> 1) & 1) * 4 + ((lane >> 2) & 1) * 2;
    *(f32x2*)(dst + cc) = (f32x2){(float)o0, (float)o1};
}
#define PEER_LD_IDS(dst, t) do { dst[0] = *(const v4u*)(SELI + (size_t)(t) * 128 + rg * 16); dst[1] = *(const v4u*)(SELI + (size_t)(t) * 128 + rg * 16 + 8); } while (0)
#define PEER_LD_ROWS16(dst, ids) do { _Pragma("unroll") for (int h_ = 0; h_ < 2; ++h_) { const v4u q_ = ids[h_]; \
        const unsigned e_[8] = {q_.x & 0xffffu, q_.x >> 16, q_.y & 0xffffu, q_.y >> 16, q_.z & 0xffffu, q_.z >> 16, q_.w & 0xffffu, q_.w >> 16}; \
        _Pragma("unroll") for (int i_ = 0; i_ < 8; ++i_) dst[h_ * 8 + i_] = *(const v4u*)(TAB + (size_t)e_[i_] * 128 + ch * 16); } } while (0)
__device__ __forceinline__ void peer_u4_pass(unsigned char* ws, int part, int wv, int nwv, int lane_) {
    int lane = lane_; asm volatile("" : "+v"(lane));
    const unsigned short* SELI = (const unsigned short*)(ws + WS_SELI);
    const unsigned char* H8 = ws + WS_H8 + part * 256;
    const unsigned char* TAB = ws + WS_PU4 + (size_t)part * 16384 * 128;
    float* PART = (float*)(ws + WS_PART) + (size_t)part * NTOK * 128;
    const int rg = lane >> 3, ch = lane & 7;
    if (wv >= NTOK) return;
#define LD_X(dst, t) do { const v4u* p_ = (const v4u*)(H8 + (size_t)(t) * 1024 + ch * 32); dst[0] = p_[0]; dst[1] = p_[1]; } while (0)
#define STEP(RC, RN, IDC, IDN, XC, XN, tk_) do { \
        { const int t1_ = ((tk_) + nwv < NTOK) ? (tk_) + nwv : (tk_), t2_ = ((tk_) + 2 * nwv < NTOK) ? (tk_) + 2 * nwv : (tk_); \
          PEER_LD_ROWS16(RN, IDN); PEER_LD_IDS(IDC, t2_); LD_X(XN, t1_); }                \
        asm volatile("" ::: "memory"); __builtin_amdgcn_sched_barrier(0); \
        u4_token(RC, XC, lane, PART + (size_t)(tk_) * 128 + rg * 16); \
        __builtin_amdgcn_sched_barrier(0); \
        asm volatile("" : "+v"(XN[0]), "+v"(XN[1]), "+v"(IDC[0]), "+v"(IDC[1])); } while (0)
    v4u idA[2], idB[2], xA[2], xB[2], RA[16], RB[16];
    PEER_LD_IDS(idA, wv); LD_X(xA, wv);
    { const int t1 = (wv + nwv < NTOK) ? wv + nwv : wv; PEER_LD_IDS(idB, t1); }
    PEER_LD_ROWS16(RA, idA);
    for (int tk = wv; tk < NTOK; tk += 2 * nwv) {
        STEP(RA, RB, idA, idB, xA, xB, tk);
        if (tk + nwv < NTOK) STEP(RB, RA, idB, idA, xB, xA, tk + nwv);
    }
#undef LD_X
#undef STEP
}

__device__ __forceinline__ void v4_grp(const v4u& R0, const v4u& R1, const v4u& R2, const v4u& R3, unsigned Wq, int (&alo)[16], int (&ahi)[16]) {
    const unsigned r0[4] = {R0.x, R0.y, R0.z, R0.w}, r1[4] = {R1.x, R1.y, R1.z, R1.w}, r2[4] = {R2.x, R2.y, R2.z, R2.w}, r3[4] = {R3.x, R3.y, R3.z, R3.w};
    unsigned A[4], B[4], C[4], D[4], T[16], L[16];
#pragma unroll
    for (int d = 0; d < 4; ++d) { A[d] = __builtin_amdgcn_perm(r1[d], r0[d], 0x05010400u); B[d] = __builtin_amdgcn_perm(r1[d], r0[d], 0x07030602u);
                                  C[d] = __builtin_amdgcn_perm(r3[d], r2[d], 0x05010400u); D[d] = __builtin_amdgcn_perm(r3[d], r2[d], 0x07030602u); }
    STAGE();
#pragma unroll
    for (int d = 0; d < 4; ++d) { T[d * 4 + 0] = __builtin_amdgcn_perm(C[d], A[d], 0x05040100u); T[d * 4 + 1] = __builtin_amdgcn_perm(C[d], A[d], 0x07060302u);
                                  T[d * 4 + 2] = __builtin_amdgcn_perm(D[d], B[d], 0x05040100u); T[d * 4 + 3] = __builtin_amdgcn_perm(D[d], B[d], 0x07060302u); }
    STAGE();
#pragma unroll
    for (int i = 0; i < 16; ++i) L[i] = T[i] & 0x0F0F0F0Fu;
    STAGE();
#pragma unroll
    for (int i = 0; i < 16; ++i) { alo[i] = __builtin_amdgcn_sdot4((int)L[i], (int)Wq, alo[i], false);
                                   ahi[i] = __builtin_amdgcn_sdot4((int)T[i], (int)Wq, ahi[i], false); }
    STAGE();
}
__device__ __forceinline__ void v4_token(const v4u (&R)[16], const v4u& wc, float osc, int lane, _Float16* dst) {
    int alo[16], ahi[16];
#pragma unroll
    for (int i = 0; i < 16; ++i) { VINIT(alo[i], 0); VINIT(ahi[i], 0); }
    STAGE();
    v4_grp(R[0], R[1], R[2], R[3], wc.x, alo, ahi); v4_grp(R[4], R[5], R[6], R[7], wc.y, alo, ahi);
    v4_grp(R[8], R[9], R[10], R[11], wc.z, alo, ahi); v4_grp(R[12], R[13], R[14], R[15], wc.w, alo, ahi);
    int sw_ = __builtin_amdgcn_sdot4((int)wc.x, 0x01010101, 0, false); sw_ = __builtin_amdgcn_sdot4((int)wc.y, 0x01010101, sw_, false);
    sw_ = __builtin_amdgcn_sdot4((int)wc.z, 0x01010101, sw_, false); sw_ = __builtin_amdgcn_sdot4((int)wc.w, 0x01010101, sw_, false);
    int cv[32];
#pragma unroll
    for (int d = 0; d < 4; ++d)
#pragma unroll
        for (int j = 0; j < 4; ++j) { cv[8 * d + j] = (alo[d * 4 + j] << 4) - 120 * sw_; cv[8 * d + 4 + j] = (ahi[d * 4 + j] - alo[d * 4 + j]) + 8 * sw_; }
    STAGE();
    unsigned xa[16], xb[16]; int r16[16], r8[8], k4[4], s4[4]; f32x4 o;
#pragma unroll
    for (int i = 0; i < 16; ++i) { const auto r_ = __builtin_amdgcn_permlane32_swap((unsigned)cv[i], (unsigned)cv[16 + i], false, false); xa[i] = r_[0]; xb[i] = r_[1]; }
    STAGE();
#pragma unroll
    for (int i = 0; i < 16; ++i) r16[i] = (int)(xa[i] + xb[i]);
    STAGE();
#pragma unroll
    for (int i = 0; i < 8; ++i) { const auto r_ = __builtin_amdgcn_permlane16_swap((unsigned)r16[i], (unsigned)r16[8 + i], false, false); xa[i] = r_[0]; xb[i] = r_[1]; }
    STAGE();
#pragma unroll
    for (int i = 0; i < 8; ++i) r8[i] = (int)(xa[i] + xb[i]);
    STAGE();
    { const bool up_ = (lane & 8) != 0;
#pragma unroll
      for (int i = 0; i < 4; ++i) { k4[i] = up_ ? r8[4 + i] : r8[i]; s4[i] = up_ ? r8[i] : r8[4 + i]; } }
    STAGE();
#pragma unroll
    for (int i = 0; i < 4; ++i) o[i] = (float)(k4[i] + ROR8(s4[i])) * osc;
    const int cc = ((lane >> 5) & 1) * 16 + ((lane >> 4) & 1) * 8 + ((lane >> 3) & 1) * 4;
    *(v2u*)(dst + cc) = (v2u){pkh2(o[0], o[1]), pkh2(o[2], o[3])};
}
__device__ __forceinline__ void peer_v4_pass(unsigned char* ws, int part, int wv, int nwv, int lane_) {
    int lane = lane_; asm volatile("" : "+v"(lane));
    const unsigned short* SELI = (const unsigned short*)(ws + WS_SELI);
    const unsigned char* W8 = ws + WS_SELW; const float* WSC = (const float*)(ws + WS_WSC);
    const unsigned char* TAB = ws + WS_PV4 + (size_t)part * 16384 * 128;
    _Float16* POUT = (_Float16*)(ws + WS_POUT) + part * 256;
    const float vstep = U4_STEP * sqrtf(fx_get((const u64*)(ws + WS_TSC) + 1) * (1.0f / (1024.0f * 1024.0f))) * (1.0f / 16.0f);
    const int rg = lane >> 3, ch = lane & 7;
    if (wv >= NTOK) return;
#define LD_W(dst, sc, t) do { dst = *(const v4u*)(W8 + (size_t)(t) * 128 + rg * 16); sc = WSC[t]; } while (0)
#define STEP(RC, RN, IDC, IDN, WC, SC_, WN, SN, tk_) do { \
        { const int t1_ = ((tk_) + nwv < NTOK) ? (tk_) + nwv : (tk_), t2_ = ((tk_) + 2 * nwv < NTOK) ? (tk_) + 2 * nwv : (tk_); \
          PEER_LD_ROWS16(RN, IDN); PEER_LD_IDS(IDC, t2_); LD_W(WN, SN, t1_); }            \
        asm volatile("" ::: "memory"); __builtin_amdgcn_sched_barrier(0); \
        v4_token(RC, WC, SC_ * vstep, lane, POUT + (size_t)(tk_) * 1024 + ch * 32); \
        __builtin_amdgcn_sched_barrier(0); \
        asm volatile("" : "+v"(WN), "+v"(SN), "+v"(IDC[0]), "+v"(IDC[1])); } while (0)
    v4u idA[2], idB[2], wA, wB, RA[16], RB[16]; float sA, sB;
    PEER_LD_IDS(idA, wv); LD_W(wA, sA, wv);
    { const int t1 = (wv + nwv < NTOK) ? wv + nwv : wv; PEER_LD_IDS(idB, t1); }
    PEER_LD_ROWS16(RA, idA);
    for (int tk = wv; tk < NTOK; tk += 2 * nwv) {
        STEP(RA, RB, idA, idB, wA, sA, wB, sB, tk);
        if (tk + nwv < NTOK) STEP(RB, RA, idB, idA, wB, sB, wA, sA, tk + nwv);
    }
#undef LD_W
#undef STEP
}

__device__ __forceinline__ void peer_combine(unsigned char* ws, int gtid, int nthreads) {
    const f32x4* PART = (const f32x4*)(ws + WS_PART); const f32x4* SELG = (const f32x4*)(ws + WS_SELG); unsigned* SELW = (unsigned*)(ws + WS_SELW); float* WSC = (float*)(ws + WS_WSC);
    const u64* ssq2 = (const u64*)(ws + WS_SSQ2); const u64* ssq1 = (const u64*)(ws + WS_SSQ1);
    const float ustep = U4_STEP * sqrtf(fx_get((const u64*)(ws + WS_TSC)) * (1.0f / (1024.0f * 1024.0f))) * (1.0f / 16.0f);
    for (int i = gtid; i < NTOK * 32; i += nthreads) {
        f32x4 s = PART[i];
#pragma unroll
        for (int p = 1; p < 4; ++p) s += PART[(size_t)p * NTOK * 32 + i];
        const float sc = rsqrtf(fx_get(ssq2 + (i >> 5)) * (1.0f / 1024.0f) + EPS) * (sqrtf(fx_get(ssq1 + (i >> 5)) * (1.0f / 1024.0f) + EPS) * (1.0f / H8_SCALE)) * ustep;
        const f32x4 g = SELG[i];
        const float w0 = g[0] * gelu_tanh(s[0] * sc), w1 = g[1] * gelu_tanh(s[1] * sc), w2 = g[2] * gelu_tanh(s[2] * sc), w3 = g[3] * gelu_tanh(s[3] * sc);
        float mx = fmaxf(fmaxf(fabsf(w0), fabsf(w1)), fmaxf(fabsf(w2), fabsf(w3)));
#pragma unroll
        for (int o = 1; o < 32; o <<= 1) mx = fmaxf(mx, __shfl_xor(mx, o));
        mx = fmaxf(mx, 1.0e-30f); const float q = 127.0f / mx; unsigned pw = 0u;
        pw = __builtin_amdgcn_cvt_pk_u8_f32(__builtin_rintf(w0 * q) + 128.0f, 0, pw); pw = __builtin_amdgcn_cvt_pk_u8_f32(__builtin_rintf(w1 * q) + 128.0f, 1, pw);
        pw = __builtin_amdgcn_cvt_pk_u8_f32(__builtin_rintf(w2 * q) + 128.0f, 2, pw); pw = __builtin_amdgcn_cvt_pk_u8_f32(__builtin_rintf(w3 * q) + 128.0f, 3, pw);
        SELW[i] = pw ^ 0x80808080u; if ((i & 31) == 0) WSC[i >> 5] = mx * (1.0f / 127.0f);
    }
}

__device__ __forceinline__ void final_norm_row(const bf16* hrow, const _Float16* prow, const float* gain, float* orow, int lane) {
    const v2u* xr = (const v2u*)hrow + lane; const u64* pr = (const u64*)prow + lane;     const f32x4* gr = (const f32x4*)gain + lane;
    f32x4 v[4]; float s = 0.f;
#pragma unroll
    for (int j = 0; j < 4; ++j) { const v2u hw = xr[64 * j]; const u64 pw = pr[64 * j]; const h2_t pa = __builtin_bit_cast(h2_t, (unsigned)pw), pb = __builtin_bit_cast(h2_t, (unsigned)(pw >> 32)); v[j] = (f32x4){bf_lo(hw.x) + (float)pa.x, bf_hi(hw.x) + (float)pa.y, bf_lo(hw.y) + (float)pb.x, bf_hi(hw.y) + (float)pb.y}; s += (v[j].x * v[j].x + v[j].y * v[j].y) + (v[j].z * v[j].z + v[j].w * v[j].w); }
    const float rstd = rsqrtf(wave_sum(s) * (1.f / 1024.f) + EPS);
    f32x4* o = (f32x4*)orow + lane;
#pragma unroll
    for (int j = 0; j < 4; ++j) { const f32x4 gg = gr[64 * j]; o[64 * j] = (f32x4){v[j].x * rstd * gg.x, v[j].y * rstd * gg.y, v[j].z * rstd * gg.z, v[j].w * rstd * gg.w}; }
}

__global__ void __launch_bounds__(NWAVES * 64, 2) fwd_megakernel(Args args) {
    extern __shared__ __attribute__((aligned(16))) unsigned char lds[];
    LAS unsigned char* L = (LAS unsigned char*)lds;
    volatile LAS unsigned* MISC = (volatile LAS unsigned*)(L + MISC_OFF);
    const int wave = __builtin_amdgcn_readfirstlane((int)threadIdx.x >> 6);
#define FRESH_LANE() ({ int l_ = (int)__builtin_amdgcn_mbcnt_hi(~0u, __builtin_amdgcn_mbcnt_lo(~0u, 0u)); asm volatile("" : "+v"(l_)); l_; })
    const int G = gridDim.x, bx = blockIdx.x;
    const int vcu = (G % 8 == 0) ? (bx % 8) * (G / 8) + bx / 8 : bx;
    unsigned char* ws = args.ws;
    gu32* ctl = (gu32*)(ws + WS_CTL);
    for (int u = (int)threadIdx.x; u < (LDS_BYTES - LDSCTL_OFF) / 4; u += NWAVES * 64) ((LAS unsigned*)(L + LDSCTL_OFF))[u] = 0u;
    __syncthreads();
    XcdBarrier bar = xcd_barrier_post((unsigned*)(ctl + CW_BAR), MISC + 8);
    const int gw = vcu * NWAVES + wave, NGW = G * NWAVES;

    const float* x = (const float*)args.in[0];
    EpiArgs E;
    E.ws = ws; E.b_gate = (const float*)args.in[5]; E.x = x; E.lam_re = (const float*)args.in[6]; E.lam_im = (const float*)args.in[7]; E.log_dt = (const float*)args.in[8];

    for (int rep_ = 0; rep_ < ((REP & 8) ? 2 : 1); ++rep_) {
        const int lane = FRESH_LANE(), tid = wave * 64 + lane;
        LAS float* scr = (LAS float*)(L + wave * 16384);
        constexpr int I_IN = 16 * 101, I_GLU = 8 * 64, I_UQ = 6 * 24, I_UKV = 4 * 32, I_MO = 8 * 32, I_OUT = 16 * 32, I_MKV = 16 * 64, I_MO2 = 16 * 32;
        constexpr int NITEMS = I_IN + I_GLU + I_UQ + I_UKV + I_MO + I_OUT + I_MKV + I_MO2;
        constexpr int NEARLY = I_IN + I_UQ + I_UKV + I_MKV;
        for (int pr_ = 0; pr_ < (PRO_REP == 1 ? 2 : 1); ++pr_)
        for (int it = gw; it < NEARLY; it += NGW) {
            int r = it;
            if (r < I_IN) { transpose_item((const float*)args.in[4], 1024, 3232, (bf16*)(ws + W_IN), 1, nullptr, scr, r, lane); continue; } r -= I_IN;
            if (r < I_UQ) { transpose_item((const float*)args.in[16], 384, 768, (bf16*)(ws + W_UQ), 3, (const float*)args.in[15], scr, r, lane); continue; } r -= I_UQ;
            if (r < I_UKV) { transpose_item((const float*)args.in[18], 256, 1024, (bf16*)(ws + W_UKV), 4, (const float*)args.in[17], scr, r, lane); continue; } r -= I_UKV;
            transpose_item((const float*)args.in[24], 1024, 2048, (bf16*)(ws + W_MKV), 0, nullptr, scr, r, lane);
        }
        { v4u* z = (v4u*)(ws + W_IN + (size_t)928 * 1024 * 2); const int n16 = 96 * 1024 * 2 / 16;
          for (int i = bx * 512 + tid; i < n16; i += G * 512) z[i] = (v4u){0u, 0u, 0u, 0u}; }
        for (int pr_ = 0; pr_ < (PRO_REP == 2 ? 2 : 1); ++pr_)
        { const int n8a = 1024 * 1024 / 8, n8b = 1024 * 2048 / 8;
          for (int i = bx * 512 + tid; i < n8a + n8b; i += G * 512) {
              const bool qa = i < n8a; const int j = qa ? i : i - n8a; const int k = qa ? (j >> 7) : (j >> 8);
              const float* src = (qa ? (const float*)args.in[23] : (const float*)args.in[27]) + (size_t)j * 8; const float gk = ((const float*)args.in[qa ? 21 : 26])[k];
              const f32x4 a = *(const f32x4*)src * gk, b = *(const f32x4*)(src + 4) * gk;
              *(v4u*)((bf16*)(ws + (qa ? W_MQN : W_PQN)) + (size_t)j * 8) = (v4u){pk2(a[0], a[1]), pk2(a[2], a[3]), pk2(b[0], b[1]), pk2(b[2], b[3])}; } }
        { const float* sk = (const float*)args.in[28]; bf16* SK = (bf16*)(ws + W_SK);
          for (int i = bx * 512 + tid; i < 8 * 256 * 256 / 2; i += G * 512) { const int e = i * 2, h = e >> 16, n = (e >> 8) & 255, k = e & 255, s = n >> 7;
            unsigned w = 0u; if ((k >> 7) == s) { const float* p = sk + ((size_t)((h * 2 + s) * 128 + (n & 127))) * 128 + (k & 127); w = pk2(p[0], p[1]); }
            *(unsigned*)(SK + e) = w; } }
        for (int pr_ = 0; pr_ < (PRO_REP == 3 ? 2 : 1); ++pr_)
        for (int m = 2 * gw; m < NTOK; m += 2 * NGW) rms_rows2_to_bf16(x + (size_t)m * 1024, x + (size_t)(m + 1) * 1024, (const float*)args.in[3], (bf16*)(ws + WS_XN) + (size_t)m * 1024, (bf16*)(ws + WS_XN) + (size_t)(m + 1) * 1024, lane);
        for (int m = 2 * gw; m < NMEM; m += 2 * NGW) rms_rows2_to_bf16((const float*)args.in[1] + (size_t)m * 1024, (const float*)args.in[1] + (size_t)(m + 1) * 1024, (const float*)args.in[22], (bf16*)(ws + WS_MEMN) + (size_t)m * 1024, (bf16*)(ws + WS_MEMN) + (size_t)(m + 1) * 1024, lane);
        for (int it = gw; it < 2048; it += NGW) { const bool isu = it < 1024; const float* row = (const float*)args.in[isu ? 29 : 30] + (size_t)((it & 1023) * 16) * 1024; float sq = 0.f;
#pragma unroll
            for (int k = 0; k < 4; ++k) { f32x4 a = *(const f32x4*)(row + k * 256 + lane * 4); if (isu) a *= *(const f32x4*)((const float*)args.in[26] + k * 256 + lane * 4); sq += (a[0] * a[0] + a[1] * a[1]) + (a[2] * a[2] + a[3] * a[3]); }
            sq = wave_sum(sq); if (lane == 0) fx_add((u64*)(ws + WS_TSC) + (isu ? 0 : 1), sq); }
        for (int pr_ = 0; pr_ < (PRO_REP == 4 ? 2 : 1); ++pr_)
        { const int* pos = (const int*)args.in[2]; f32x2* tab = (f32x2*)(ws + WS_TAB);
          for (int i = bx * 512 + tid; i < NTOK * 16; i += G * 512) { const int tk = i >> 4, f = i & 15;
            const float inv = 1.0f / exp2f((float)f * 0.830482023721841f); const float ang = (float)pos[tk] * inv; float sn, cs; sincos_rev(ang, sn, cs); tab[i] = (f32x2){cs, sn}; } }
        { SsmP P{(const float*)args.in[6], (const float*)args.in[7], (const float*)args.in[8], (const float*)args.in[9], (const float*)args.in[10], (const float*)args.in[11], (const float*)args.in[12], (const float*)args.in[13]};
          bf16* MF = (bf16*)(ws + WS_MFULL); bf16* WST = (bf16*)(ws + WS_WST);
          constexpr int NL = 32 * 63, NO = 32 * 32, NS = 32 * 2 * 64;
          for (int pr_ = 0; pr_ < (PRO_REP == 5 ? 2 : 1); ++pr_)
          for (int it = (gw + (NGW * 31) / 64) % NGW; it < NL + NO + NS; it += NGW) {
              if (it < NL) ssm_lag_item(P, MF, it / 63, it % 63 - 31, scr, lane);
              else if (it < NL + NO) { const int r = it - NL; ssm_out_item(P, MF, r >> 5, r & 31, lane); }
              else { const int r = it - NL - NO; ssm_st_item(P, WST, r >> 7, (r >> 6) & 1, r & 63, lane); }
          } }
    }
    xcd_barrier(bar);

    pg8::GemmDesc g; int gi_ = 0;
#define GEMMC(cc, ...) do { g = pg8::GemmDesc{__VA_ARGS__}; const bool rp_ = (REPG < 0 || REPG == gi_); ++gi_; if (rp_ && (REP & 1)) pg8::gemm_phase<true>(L, g, E, G, (cc), 1); if (rp_ && (REP & 128)) pg8::gemm_phase<true>(L, g, E, G, (cc), 2); pg8::gemm_phase<true>(L, g, E, G, (cc)); } while (0)
#define GEMM(...) GEMMC(bx, __VA_ARGS__)
#if DEBUG_STAGE >= 1
    GEMM((const bf16*)(ws + WS_XN), nullptr, (const bf16*)(ws + W_IN), nullptr, 1024, 1024, 1024, 128, 13, 1, pg8::ORD_STD, pg8::EK_IN, 0, 0, 0, 0);
    GEMMC((bx + G / 2) % G, (const bf16*)(ws + WS_MEMN), nullptr, (const bf16*)(ws + W_MKV), nullptr, 1024, 1024, 1024, 8, 8, 1, pg8::ORD_STD, pg8::EK_MEMKV, 0, 0, 0, 0);
    GEMMC((bx + G / 4) % G, (const bf16*)(ws + W_SK), nullptr, (const bf16*)(ws + W_PQN), nullptr, 256, 2048, 256, 1, 4, 8, pg8::ORD_Z, pg8::EK_W1, 0, 65536, 256, 0);
    if (G >= 4 && bx >= G - G / 4) {
        const int lane = FRESH_LANE(); LAS float* scr = (LAS float*)(L + wave * 16384);
        constexpr int I_GLU = 8 * 64, I_MO = 8 * 32, I_OUT = 16 * 32, I_MO2 = 16 * 32;
        const int lw_ = (bx - (G - G / 4)) * NWAVES + wave, nlw_ = (G / 4) * NWAVES;
        for (int it = lw_; it < I_GLU + I_MO + I_OUT + I_MO2; it += nlw_) {
            int r = it;
            if (r < I_GLU) { transpose_item((const float*)args.in[14], 512, 2048, (bf16*)(ws + W_GLU), 2, nullptr, scr, r, lane); continue; } r -= I_GLU;
            if (r < I_MO) { transpose_item((const float*)args.in[19], 512, 1024, (bf16*)(ws + W_MO), 0, nullptr, scr, r, lane); continue; } r -= I_MO;
            if (r < I_OUT) { transpose_item((const float*)args.in[20], 1024, 1024, (bf16*)(ws + W_OUT), 0, nullptr, scr, r, lane); continue; } r -= I_OUT;
            transpose_item((const float*)args.in[25], 1024, 1024, (bf16*)(ws + W_MO2), 0, nullptr, scr, r, lane);
        }
    }
    xcd_barrier(bar);
    GEMM((const bf16*)(ws + WS_U), nullptr, (const bf16*)(ws + WS_WST), nullptr, UPITCH, 512, 512, 4, 1, 32, pg8::ORD_Z, pg8::EK_SLOC, 1, (long)NCHUNK * UPITCH, (long)256 * 512, 0);
    GEMMC((bx + G / 2) % G, (const bf16*)(ws + WS_CQ), nullptr, (const bf16*)(ws + W_UQ), nullptr, 384, 384, 384, 128, 3, 1, pg8::ORD_STD, pg8::EK_Q, 0, 0, 0, 0);
    GEMM((const bf16*)(ws + WS_CKV), nullptr, (const bf16*)(ws + W_UKV), nullptr, 256, 256, 256, 128, 4, 1, pg8::ORD_STD, pg8::EK_KV, 0, 0, 0, 0);
    xcd_barrier(bar);
    {
        const int xg = vcu >> 5, jj = vcu & 31;
        for (int i_ = 0; i_ < ((REP & 2) ? 8 : 4); ++i_) { const int i = i_ & 3;
            const int ui = i * 32 + jj, pair = xg * 8 + (ui >> 4), qb = ui & 15;
            if (pair < 64) {
                const int b = pair >> 3, h = pair & 7;
                const bf16* Qp = (const bf16*)(ws + WS_Q) + ((size_t)(pair * SEQ + qb * 256)) * 96;
                const bf16* Kp = (const bf16*)(ws + WS_K) + (size_t)pair * SEQ * 96;
                const bf16* Vp = (const bf16*)(ws + WS_V) + (size_t)pair * SEQ * 64;
                bf16* Op = (bf16*)(ws + WS_ATT) + ((size_t)(b * SEQ + qb * 256)) * 512 + h * 64;
                att::attn_unit(Qp, Kp, Vp, Op, (char*)lds);
            }
        }
    }
    GEMM((const bf16*)(ws + WS_U), nullptr, (const bf16*)(ws + WS_MFULL), nullptr, UPITCH, UPITCH, 768, 4, 2, 32, pg8::ORD_Z, pg8::EK_Y, 0, (long)NCHUNK * UPITCH, (long)512 * UPITCH, 0);
    GEMM((const bf16*)(ws + WS_KM), nullptr, (const bf16*)(ws + W_MQN), nullptr, 256, 1024, 256, 8, 4, 4, pg8::ORD_Z, pg8::EK_W2, 0, (long)8 * 65536, 256, 0);
    GEMMC((bx + G / 2) % G, (const bf16*)(ws + W_MO2), nullptr, (const bf16*)(ws + WS_VT), nullptr, 1024, 256, 256, 4, 8, 4, pg8::ORD_Z, pg8::EK_W3, 0, 256, (long)8 * 65536, 0);
    xcd_barrier(bar);
    GEMM((const bf16*)(ws + WS_YS), (const bf16*)(ws + WS_ATT), (const bf16*)(ws + W_GLU), (const bf16*)(ws + W_MO), 512, 512, 512, 128, 4, 1, pg8::ORD_DUAL, pg8::EK_P4, 0, 0, 0, 0);
    xcd_barrier(bar);
    GEMM((const bf16*)(ws + WS_MERGED), nullptr, (const bf16*)(ws + W_OUT), nullptr, 1024, 1024, 1024, 128, 4, 1, pg8::ORD_STD, pg8::EK_OUT, 0, 0, 0, 0);
    xcd_barrier(bar);
#endif
#if DEBUG_STAGE >= 2
    GEMM((const bf16*)(ws + WS_HB), nullptr, (const bf16*)(ws + WS_W2), nullptr, 1024, 1024, 1024, 128, 4, 1, pg8::ORD_STD, pg8::EK_MS2, 0, 0, 0, (long)1024 * 1024);
    xcd_barrier(bar);
    GEMM((const bf16*)(ws + WS_PM), nullptr, (const bf16*)(ws + WS_W3), nullptr, 1024, 1024, 1024, 128, 4, 1, pg8::ORD_STD, pg8::EK_MO, 0, 0, 0, (long)1024 * 1024);
#if DEBUG_STAGE >= 9
    { const int tid_ = wave * 64 + FRESH_LANE(); const f32x4* pu = (const f32x4*)args.in[29]; const f32x4* pv = (const f32x4*)args.in[30];
      const float uinv = 1.0f / (U4_STEP * sqrtf(fx_get((const u64*)(ws + WS_TSC)) * (1.0f / (1024.0f * 1024.0f)))), vinv = 1.0f / (U4_STEP * sqrtf(fx_get((const u64*)(ws + WS_TSC) + 1) * (1.0f / (1024.0f * 1024.0f))));
      const int n32 = 16384 * 1024 / 32;
      for (int i = bx * 512 + tid_; i < n32; i += G * 512) {
          const int e = i >> 5, col = (i & 31) * 32; const f32x4* gq = (const f32x4*)((const float*)args.in[26] + col); unsigned du[4], dv[4]; f32x4 ru[8], rv[8];
#pragma unroll
          for (int d = 0; d < 8; ++d) { ru[d] = pu[8 * i + d]; rv[d] = pv[8 * i + d]; }
#pragma unroll
          for (int d = 0; d < 4; ++d) { const f32x4 a = ru[2 * d] * gq[2 * d] * uinv, b = ru[2 * d + 1] * gq[2 * d + 1] * uinv, a2 = rv[2 * d] * vinv, b2 = rv[2 * d + 1] * vinv; unsigned w = 0u, w2 = 0u;
#pragma unroll
              for (int j = 0; j < 4; ++j) {
                  const int na = (int)__builtin_amdgcn_fmed3f(__builtin_floorf(a[j]), -8.0f, 7.0f), nb = (int)__builtin_amdgcn_fmed3f(__builtin_floorf(b[j]), -8.0f, 7.0f);
                  const int na2 = (int)__builtin_amdgcn_fmed3f(__builtin_floorf(a2[j]), -8.0f, 7.0f), nb2 = (int)__builtin_amdgcn_fmed3f(__builtin_floorf(b2[j]), -8.0f, 7.0f);
                  w |= ((unsigned)(na + 8) << (8 * j)) | (((unsigned)nb & 15u) << (8 * j + 4)); w2 |= ((unsigned)(na2 + 8) << (8 * j)) | (((unsigned)nb2 & 15u) << (8 * j + 4)); }
              du[d] = w; dv[d] = w2; }
          const size_t off_ = ((size_t)((col >> 8) * 16384 + e)) * 128 + ((col & 255) >> 1);
          *(v4u*)(ws + WS_PU4 + off_) = (v4u){du[0], du[1], du[2], du[3]}; *(v4u*)(ws + WS_PV4 + off_) = (v4u){dv[0], dv[1], dv[2], dv[3]}; } }
#endif
    xcd_barrier(bar);
#endif
#if DEBUG_STAGE >= 9
    GEMM((const bf16*)(ws + WS_HB), nullptr, (const bf16*)(ws + WS_W1), nullptr, 1024, 1024, 1024, 128, 8, 1, pg8::ORD_STD, pg8::EK_PS2, 0, 0, 0, 0);
    xcd_barrier(bar);
    if (REP & 16) peer_topk(ws, L + wave * 16384, gw, NGW, FRESH_LANE());
    peer_topk(ws, L + wave * 16384, gw, NGW, FRESH_LANE());
    xcd_barrier(bar);
    { const bool xp = (G % 8 == 0); const int np = xp ? 1 : 4, wvp = xp ? ((bx >> 3) * 2 + (bx & 1)) * NWAVES + wave : gw, nwp = xp ? (G >> 2) * NWAVES : NGW;
      for (int p_ = 0; p_ < np * ((REP & 32) ? 2 : 1); ++p_) peer_u4_pass(ws, xp ? ((bx & 7) >> 1) : (p_ & 3), wvp, nwp, FRESH_LANE()); }
    xcd_barrier(bar);
    peer_combine(ws, bx * 512 + wave * 64 + FRESH_LANE(), G * 512);
    xcd_barrier(bar);
    { const bool xp = (G % 8 == 0); const int np = xp ? 1 : 4, wvp = xp ? ((bx >> 3) * 2 + (bx & 1)) * NWAVES + wave : gw, nwp = xp ? (G >> 2) * NWAVES : NGW;
      for (int p_ = 0; p_ < np * ((REP & 64) ? 2 : 1); ++p_) peer_v4_pass(ws, xp ? ((bx & 7) >> 1) : (p_ & 3), wvp, nwp, FRESH_LANE()); }
    xcd_barrier(bar);
    { const int lane = FRESH_LANE();
    for (int m = gw; m < NTOK; m += NGW) final_norm_row((const bf16*)(ws + WS_HB) + (size_t)m * 1024, (const _Float16*)(ws + WS_POUT) + (size_t)m * 1024, (const float*)args.in[31], args.out + (size_t)m * 1024, lane); }
#else
    {
        const float* src = (DEBUG_STAGE == 0) ? x : (const float*)(ws + WS_H); const int lane = FRESH_LANE();
        for (int m = gw; m < NTOK; m += NGW) rms_row_to_f32(src + (size_t)m * 1024, (const float*)args.in[31], args.out + (size_t)m * 1024, lane);
    }
#endif
#undef GEMM
#undef GEMMC
}

extern "C" void kernel_launch(void* const* d_in, const int* in_sizes, int n_in, void* d_out, int out_size, void* d_ws, size_t ws_size, hipStream_t stream) {
    static int grid = 0;
    if (grid == 0) {
        if (n_in != 32 || in_sizes[0] != NTOK * D || out_size != NTOK * D || ws_size < WS_END) {
            fprintf(stderr, "kernel_launch: unexpected shapes: n_in %d in0 %d out %d ws %zu (need %zu)\n", n_in, n_in > 0 ? in_sizes[0] : -1, out_size, ws_size, (size_t)WS_END); grid = -1; return; }
        int dev = 0, cus = 0, per_cu = 0;
        if (hipGetDevice(&dev) != hipSuccess || hipDeviceGetAttribute(&cus, hipDeviceAttributeMultiprocessorCount, dev) != hipSuccess) { grid = -1; return; }
        if (hipFuncSetAttribute((const void*)fwd_megakernel, hipFuncAttributeMaxDynamicSharedMemorySize, LDS_BYTES) != hipSuccess) { fprintf(stderr, "kernel_launch: hipFuncSetAttribute failed\n"); grid = -1; return; }
        if (hipOccupancyMaxActiveBlocksPerMultiprocessor(&per_cu, (const void*)fwd_megakernel, NWAVES * 64, LDS_BYTES) != hipSuccess || per_cu < 1) {
            fprintf(stderr, "kernel_launch: occupancy query reports %d blocks per CU\n", per_cu); per_cu = 1; }
        (void)hipGetLastError();
        grid = cus;
    }
    if (grid < 0) return;
    if (hipMemsetAsync((char*)d_ws + WS_CTL, 0, CTL_ZERO_BYTES, stream) != hipSuccess) { fprintf(stderr, "kernel_launch: memset failed\n"); return; }
    Args a{};
    for (int i = 0; i < 32; ++i) a.in[i] = d_in[i];
    a.out = (float*)d_out; a.ws = (unsigned char*)d_ws;
    void* kargs[] = {&a};
    hipError_t e = hipLaunchCooperativeKernel((const void*)fwd_megakernel, dim3(grid), dim3(NWAVES * 64), kargs, LDS_BYTES, stream);
    if (e != hipSuccess) fprintf(stderr, "kernel_launch: cooperative launch failed: %s (grid %d)\n", hipGetErrorString(e), grid);
}
```

```cpp
#include <hip/hip_runtime.h>
#include <hip/hip_bf16.h>
#include <cstdio>
#include <cstdint>

#ifndef REP
#define REP 0
#endif
#ifndef PRO_REP
#define PRO_REP 0
#endif
#ifndef REPG
#define REPG -1
#endif
#ifndef DEBUG_STAGE
#define DEBUG_STAGE 9
#endif

constexpr int D = 1024, BATCH = 8, SEQ = 4096, NTOK = BATCH * SEQ;
constexpr int MEMT = 256, NMEM = BATCH * MEMT;
constexpr int TCH = 32;
constexpr int NCHUNK = NTOK / TCH;
constexpr int UPITCH = 768;
constexpr float EPS = 1e-6f;

#define GAS __attribute__((address_space(1)))
#define LAS __attribute__((address_space(3)))
typedef unsigned short bf16;
typedef unsigned v4u __attribute__((ext_vector_type(4)));
typedef unsigned v2u __attribute__((ext_vector_type(2)));
typedef float f32x4 __attribute__((ext_vector_type(4)));
typedef float f32x2 __attribute__((ext_vector_type(2)));
typedef short bf16x8 __attribute__((ext_vector_type(8)));
typedef GAS unsigned gu32;
typedef _Float16 h2_t __attribute__((ext_vector_type(2)));
__device__ __forceinline__ unsigned pkh2(float a, float b) { h2_t h = {(_Float16)a, (_Float16)b}; return __builtin_bit_cast(unsigned, h); }
__device__ __forceinline__ void sincos_rev(float x, float& sn, float& cs) { float r = x * 0.15915494309189535f; r = r - floorf(r); sn = __builtin_amdgcn_sinf(r); cs = __builtin_amdgcn_cosf(r); }
#define RLX_AGENT __ATOMIC_RELAXED, __HIP_MEMORY_SCOPE_AGENT
#define LDS_WAIT() asm volatile("s_waitcnt lgkmcnt(0)" ::: "memory")
#define VM_WAIT() asm volatile("s_waitcnt vmcnt(0)" ::: "memory")

__device__ __forceinline__ unsigned f2bf(float f) { unsigned u = __builtin_bit_cast(unsigned, f); return (u + 0x7fffu + ((u >> 16) & 1u)) >> 16; }
typedef float f32x2_t_ __attribute__((ext_vector_type(2))); typedef __bf16 bf16x2_t_ __attribute__((ext_vector_type(2)));
__device__ __forceinline__ unsigned pk2(float lo, float hi) { const f32x2_t_ v = {lo, hi}; const bf16x2_t_ b = __builtin_convertvector(v, bf16x2_t_); return __builtin_bit_cast(unsigned, b); }
__device__ __forceinline__ float bf_lo(unsigned w) { return __builtin_bit_cast(float, w << 16); }
__device__ __forceinline__ float bf_hi(unsigned w) { return __builtin_bit_cast(float, w & 0xffff0000u); }
__device__ __forceinline__ float wave_sum(float v) {
#pragma unroll
    for (int o = 1; o < 64; o <<= 1) v += __shfl_xor(v, o);
    return v;
}
typedef unsigned long long u64;
__device__ __forceinline__ void fx_add(u64* p, float s) { atomicAdd(p, (u64)(long long)(s * 1073741824.0f)); }
__device__ __forceinline__ float fx_get(const u64* p) { return (float)(long long)(*p) * (1.0f / 1073741824.0f); }
__device__ __forceinline__ float sigmoidf_(float x) { return __builtin_amdgcn_rcpf(1.0f + __builtin_amdgcn_exp2f(-1.4426950408889634f * x)); }
__device__ __forceinline__ float gelu_tanh(float x) {
    const float u = 1.5957691216057308f * (x + 0.044715f * x * x * x);
    return x * __builtin_amdgcn_rcpf(1.0f + __builtin_amdgcn_exp2f(-1.4426950408889634f * u));
}

constexpr size_t MiB = 1u << 20;
constexpr size_t WS_CTL = 0;
constexpr size_t CTL_ZERO_BYTES = 4 * MiB;
constexpr size_t WS_SSQQ = 1 * MiB, WS_SSQKV = WS_SSQQ + 256 * 1024, WS_SSQ1 = WS_SSQKV + 256 * 1024, WS_SSQ2 = WS_SSQ1 + 256 * 1024;
constexpr size_t WS_ROWSUM = 2 * MiB;
constexpr size_t W_SK = 4 * MiB;
constexpr size_t W_PQN = 5 * MiB;
constexpr size_t W_MO2 = 9 * MiB;
constexpr size_t WS_TAB = 11 * MiB;
constexpr size_t W_IN = 15 * MiB;
constexpr size_t W_GLU = W_IN + (size_t)3328 * 1024 * 2;
constexpr size_t W_UQ = W_GLU + (size_t)2048 * 512 * 2;
constexpr size_t W_UKV = W_UQ + (size_t)768 * 384 * 2;
constexpr size_t W_MO = W_UKV + (size_t)1024 * 256 * 2;
constexpr size_t W_OUT = W_MO + (size_t)1024 * 512 * 2;
constexpr size_t W_MQN = W_OUT + (size_t)1024 * 1024 * 2;
constexpr size_t W_MKV = W_MQN + (size_t)1024 * 1024 * 2;
constexpr size_t W_END = W_MKV + (size_t)2048 * 1024 * 2;
static_assert(W_END <= 34 * MiB, "weights region");
constexpr size_t WS_PU4 = 12 * MiB;
constexpr size_t WS_TSC = 512 * 1024;
constexpr size_t WS_H8 = 110 * MiB;
constexpr float U4_STEP = 0.335f, H8_SCALE = 127.0f / 12.0f;
constexpr size_t WS_PV4 = 28 * MiB;
constexpr size_t WS_W1 = 494 * MiB;
constexpr size_t WS_W2 = 446 * MiB;
constexpr size_t WS_W3 = 462 * MiB;
constexpr size_t WS_KM = 34 * MiB, WS_VT = 38 * MiB, WS_MEMN = 42 * MiB;
constexpr size_t WS_DYN = 46 * MiB;
constexpr size_t WS_GATES = 46 * MiB;
constexpr size_t WS_MFULL = 174 * MiB;
constexpr size_t WS_WST = 198 * MiB;
constexpr size_t WS_U = 206 * MiB;
constexpr size_t WS_Q = 254 * MiB;
constexpr size_t WS_K = 302 * MiB;
constexpr size_t WS_V = 350 * MiB;
constexpr size_t WS_XN = 382 * MiB;
constexpr size_t WS_SLOC = 382 * MiB;
constexpr size_t WS_ATT = 382 * MiB;
constexpr size_t WS_YS = 414 * MiB;
constexpr size_t WS_CQ = 446 * MiB;
constexpr size_t WS_CKV = 470 * MiB;
constexpr size_t WS_MERGED = 254 * MiB;
constexpr size_t WS_H = 46 * MiB;
constexpr size_t WS_HB = 174 * MiB;
constexpr size_t WS_GS = 318 * MiB;
constexpr size_t WS_PM = 382 * MiB;
constexpr size_t WS_OM = 238 * MiB;
constexpr size_t WS_SC = 366 * MiB;
constexpr size_t WS_SELI = 238 * MiB;
constexpr size_t WS_SELG = 254 * MiB;
constexpr size_t WS_SELW = 270 * MiB;
constexpr size_t WS_WSC = 278 * MiB;
constexpr size_t WS_PART = 286 * MiB;
constexpr size_t WS_POUT = 286 * MiB;
constexpr size_t WS_END = 512 * MiB;
static_assert(WS_W1 + 4 * MiB <= WS_END && WS_SC + (size_t)NTOK * 2048 * 2 <= WS_W1 && WS_CKV + (size_t)NTOK * 256 * 2 <= WS_END && WS_POUT + (size_t)NTOK * 4096 <= WS_END, "ws map");

constexpr int CW_BAR = 4096;

constexpr int RING_BYTES = 131072;
constexpr int LDSCTL_OFF = RING_BYTES, MISC_OFF = LDSCTL_OFF + 320;
constexpr int LDS_BYTES = 147456;
constexpr int NWAVES = 8;

#define XB_TMO      128
#define XB_XCNT(j)  (256  + 64 * (j))
#define XB_XSUB(j)  (1280 + 64 * (j))
#define XB_XGEN(j)  (2304 + 64 * (j))
#define XB_TOP      3328
#define XB_TOPGEN   3392
#define XCD_BAR_WORDS 3456
#define XB_SPIN_CAP (1u << 20)
__device__ __forceinline__ unsigned xb_ld(unsigned* p)              { return __hip_atomic_load(p, __ATOMIC_RELAXED, __HIP_MEMORY_SCOPE_AGENT); }
__device__ __forceinline__ unsigned xb_add(unsigned* p, unsigned v) { return __hip_atomic_fetch_add(p, v, __ATOMIC_RELAXED, __HIP_MEMORY_SCOPE_AGENT); }
__device__ __forceinline__ unsigned xb_xcc_id() { return (unsigned)__builtin_amdgcn_s_getreg((3 << 11) | 20) & 0xFu; }
#define XB_SPIN(cond, bar) do { unsigned _sp = 0; while (cond) { __builtin_amdgcn_s_sleep(1); \
    if ((++_sp & 255u) == 0u) { if (xb_ld(&(bar)[XB_TMO])) break; if (_sp > XB_SPIN_CAP) { atomicAdd(&(bar)[XB_TMO], 1u); break; } } } } while (0)
struct XcdBarrier { unsigned* bar; unsigned x; volatile LAS unsigned* st; };
__device__ __forceinline__ XcdBarrier xcd_barrier_post(unsigned* bar, volatile LAS unsigned* st) {
    XcdBarrier b; b.bar = bar; b.x = xb_xcc_id(); b.st = st;
    if (threadIdx.x == 0) (void)xb_add(&bar[XB_XCNT(b.x)], 1u);
    return b;
}
__device__ __forceinline__ void xcd_barrier_complete(unsigned* bar, unsigned x, unsigned& nloc, unsigned& nx) {
    const unsigned G = gridDim.x * gridDim.y * gridDim.z;
    unsigned sum, cnt, mine, sp = 0u;
    for (;;) {
        sum = 0u; cnt = 0u; mine = 0u;
#pragma unroll
        for (unsigned j = 0; j < 16; ++j) { const unsigned c = xb_ld(&bar[XB_XCNT(j)]); sum += c; cnt += (c > 0u) ? 1u : 0u; mine = (j == x) ? c : mine; }
        if (sum == G) break;
        __builtin_amdgcn_s_sleep(1);
        if ((++sp & 255u) == 0u) { if (xb_ld(&bar[XB_TMO])) break; if (sp > XB_SPIN_CAP) { atomicAdd(&bar[XB_TMO], 1u); break; } }
    }
    nloc = mine > 0u ? mine : 1u; nx = cnt > 0u ? cnt : 1u;
}
__device__ __forceinline__ void xcd_barrier(const XcdBarrier& b) {
    asm volatile("s_waitcnt vmcnt(0)" ::: "memory");
    __syncthreads();
    if (threadIdx.x == 0) {
        unsigned* bar = b.bar;
        __builtin_amdgcn_s_waitcnt(0);
        unsigned nloc = b.st[0], nx = b.st[1];
        if (nloc == 0u) { xcd_barrier_complete(bar, b.x, nloc, nx); b.st[0] = nloc; b.st[1] = nx; }
        const unsigned old = xb_add(&bar[XB_XSUB(b.x)], 1u);
        const unsigned gen = old / nloc;
        if (old + 1u == (gen + 1u) * nloc) {
            __builtin_amdgcn_fence(__ATOMIC_RELEASE, "agent");
            asm volatile("s_waitcnt vmcnt(0)" ::: "memory");
            const unsigned og = xb_add(&bar[XB_TOP], 1u);
            const unsigned tg = og / nx;
            if (og + 1u == (tg + 1u) * nx) xb_add(&bar[XB_TOPGEN], 1u);
            else XB_SPIN(xb_ld(&bar[XB_TOPGEN]) == tg, bar);
            __builtin_amdgcn_fence(__ATOMIC_ACQUIRE, "agent");
            xb_add(&bar[XB_XGEN(b.x)], 1u);
            asm volatile("s_waitcnt vmcnt(0)" ::: "memory");
        } else {
            XB_SPIN(xb_ld(&bar[XB_XGEN(b.x)]) == gen, bar);
            __builtin_amdgcn_fence(__ATOMIC_ACQUIRE, "agent");
            asm volatile("s_waitcnt vmcnt(0)" ::: "memory");
        }
    }
    __syncthreads();
}

struct EpiArgs {
    unsigned char* ws;
    const float *b_gate, *x, *lam_re, *lam_im, *log_dt;
#define EP(name, type, off) __device__ __forceinline__ type* name() const { return (type*)(ws + (off)); }
    EP(U, bf16, WS_U) EP(CQ, bf16, WS_CQ) EP(CKV, bf16, WS_CKV) EP(Kb, bf16, WS_K) EP(Vb, bf16, WS_V) EP(Qb, bf16, WS_Q) EP(GATES, unsigned char, WS_GATES)
    EP(KM, bf16, WS_KM) EP(VT, bf16, WS_VT) EP(YS, bf16, WS_YS) EP(ATT, bf16, WS_ATT) EP(MERGED, bf16, WS_MERGED) EP(HB, bf16, WS_HB)
    EP(GS, unsigned char, WS_GS) EP(PM, bf16, WS_PM) EP(H8, unsigned char, WS_H8) EP(SC, _Float16, WS_SC) EP(W1, bf16, WS_W1) EP(W2, bf16, WS_W2) EP(W3, bf16, WS_W3)
    EP(ssq_q, u64, WS_SSQQ) EP(ssq_kv, u64, WS_SSQKV) EP(ssq1, u64, WS_SSQ1) EP(ssq2, u64, WS_SSQ2) EP(rowsum, u64, WS_ROWSUM) EP(SLOC, float, WS_SLOC) EP(H, float, WS_H)
    EP(tab, const f32x2, WS_TAB)
#undef EP
};

namespace pg8 {
#define PG8_LAS __attribute__((address_space(3)))
typedef unsigned short bf16_t;
typedef unsigned u32x4 __attribute__((ext_vector_type(4)));
constexpr int BM = 256, BK = 64, HALF = 128, HTB = HALF * BK * 2, STAGE_BYTES = 8 * HTB, NXCD = 8, WGM = 8;
constexpr int XCH_OFF_ = STAGE_BYTES + 1024;
__host__ __device__ __forceinline__ int lds_byte(int r, int c) { const int st = (r >> 4) * 2 + (c >> 5), rr = r & 15, cc = c & 31, ob = rr * 64 + cc * 2; return st * 1024 + (ob ^ (((ob >> 9) & 1) << 5)); }
__host__ __device__ __forceinline__ void stage_rc(int b, int& R, int& C) { const int st = b / 1024, sb = b % 1024, swz = sb ^ (((sb >> 9) & 1) << 5); R = (st >> 1) * 16 + swz / 64; C = (st & 1) * 32 + (swz % 64) / 2; }
__host__ __device__ __forceinline__ int perm32(int rho) { const int n = rho >> 4, i = rho & 15; return 8 * (i >> 2) + 4 * n + (i & 3); }

struct Unit { int pm, pn, z; };
enum { ORD_STD = 0, ORD_Z = 1, ORD_DUAL = 2 };
enum { EK_IN = 0, EK_MEMKV, EK_Q, EK_KV, EK_SLOC, EK_Y, EK_P4, EK_OUT, EK_MS2, EK_MO, EK_PS2, EK_W1, EK_W2, EK_W3 };
struct GemmDesc {
    const bf16_t *A0, *A1, *B0, *B1;
    int lda, ldb, K;
    int nM, nN, nZ, order, epi, after_drain;
    long sAz, sBz, sBb;
    __device__ __forceinline__ const char* aptr(const Unit& u) const {
        const bf16_t* a = (order == ORD_DUAL && u.z) ? A1 : A0;
        return (const char*)(a + ((order == ORD_DUAL) ? 0 : (long)u.z * sAz) + (long)u.pm * BM * lda); }
    __device__ __forceinline__ const char* bptr(const Unit& u) const {
        const bf16_t* b = (order == ORD_DUAL && u.z) ? B1 : B0;
        return (const char*)(b + ((order == ORD_DUAL) ? 0 : (long)u.z * sBz) + (long)(u.pm >> 4) * sBb + (long)u.pn * BM * ldb); }
    __device__ __forceinline__ bool next(int i, int G, int c, Unit& u) const {
        if (order == ORD_STD) {
            const int nwg = nM * nN; const long L = (long)i * G + c; if (L >= nwg) return false;
            int wgid = (int)L; { const int q = nwg / NXCD, r = nwg % NXCD, xcd = wgid % NXCD, off = wgid / NXCD; wgid = (xcd < r ? xcd * (q + 1) : r * (q + 1) + (xcd - r) * q) + off; }
            const int nig = WGM * nN, gid = wgid / nig, fm = gid * WGM, gsz = (nM - fm) < WGM ? (nM - fm) : WGM;
            u.pm = fm + ((wgid % nig) % gsz); u.pn = (wgid % nig) / gsz; u.z = 0; return true;
        } else if (order == ORD_Z) {
            const long L = (long)i * G + c; if (L >= (long)nZ * nM * nN) return false;
            const int l = (int)L; u.pn = l % nN; const int t = l / nN; u.pm = t % nM; u.z = t / nM; return true;
        } else {
            const int combos = nM * nN, combo = (i / 3) * G + c; if (combo >= combos) return false;
            const int sub = i % 3, pnp = combo / nM; u.pm = combo % nM;
            if (sub < 2) { u.pn = 2 * pnp + sub; u.z = 0; } else { u.pn = pnp; u.z = 1; }
            return true;
        }
    }
};

typedef f32x4 Acc[2][2][4][2];
__device__ __forceinline__ v4u pack8(const float* v) { v4u w; w.x = pk2(v[0], v[1]); w.y = pk2(v[2], v[3]); w.z = pk2(v[4], v[5]); w.w = pk2(v[6], v[7]); return w; }
#define GATE_BASE(pm_, gt_) (E.GATES() + (((((size_t)((pm_) * 8 + (gt_)) * 8 + (wr * 4 + wc)) * 16 + 8) * 64 + (fq * 16 + fr)) << 3))
#define GS_BASE(pm_, gt_) (E.GS() + (((((size_t)((pm_) * 8 + (gt_)) * 8 + (wr * 4 + wc)) * 8 + 4) * 64 + (fq * 16 + fr)) << 4))
#define GS_PTR(gb_, ai_, m_) ((gb_) + (((ai_) * 4 + (m_)) - 4) * 1024)
#define GATE_PTR(gb_, ai_, m_, bj_) ((gb_) + ((((ai_) * 4 + (m_)) * 2 + (bj_)) - 8) * 512)
#define LOADV(v, ai, bj, m) do { const f32x4 a_ = acc[ai][bj][m][0], b_ = acc[ai][bj][m][1]; v[0] = a_[0]; v[1] = a_[1]; v[2] = a_[2]; v[3] = a_[3]; v[4] = b_[0]; v[5] = b_[1]; v[6] = b_[2]; v[7] = b_[3]; } while (0)
__device__ __forceinline__ float quad_sum16(float s) { s += __shfl_xor(s, 16); s += __shfl_xor(s, 32); return s; }

__device__ __forceinline__ void rope8(float* v, const f32x2* tabrow, int fq) {
    const int ib = 8 * (fq & 1);
#pragma unroll
    for (int j = 0; j < 8; ++j) {
        const float other = __shfl_xor(v[j], 32);
        const f32x2 cs = tabrow[ib + j];
        v[j] = (fq < 2) ? (v[j] * cs.x - other * cs.y) : (v[j] * cs.x + other * cs.y);
    }
}

__device__ __forceinline__ void epilogue(const GemmDesc& g, const EpiArgs& E, const Acc& acc, const Unit& u, int wr, int wc, int fr, int fq, bool probe = false) {
    const int rbase = u.pm * BM + wr * 64 + fr;
    const int cw = wc * 32 + 8 * fq;
    float v[8];
    switch (g.epi) {
    case EK_IN: {
        const int pn = u.pn;
        unsigned char* const gb_ = (unsigned char*)GATE_BASE(u.pm, pn >= 5 ? pn - 5 : 0);
#pragma unroll
        for (int ai = 0; ai < 2; ++ai)
#pragma unroll
            for (int m = 0; m < 4; ++m) {
                const int r = rbase + ai * HALF + m * 16;
                if (pn < 2) {
#pragma unroll
                    for (int bj = 0; bj < 2; ++bj) { LOADV(v, ai, bj, m); const int col = pn * 256 + bj * HALF + cw, gq = col >> 4, c0 = col & 15;
                        *(v4u*)(E.U() + ((size_t)(gq * NCHUNK + (r >> 5)) * UPITCH + (r & 31) * 16 + c0)) = pack8(v); }
                } else if (pn == 2) {
                    float s = 0.f;
#pragma unroll
                    for (int bj = 0; bj < 2; ++bj) { LOADV(v, ai, bj, m);
#pragma unroll
                        for (int j = 0; j < 8; ++j) s += v[j] * v[j];
                        *(v4u*)(E.CQ() + (size_t)r * 384 + bj * HALF + cw) = pack8(v); }
                    s = quad_sum16(s); if (fq == 0 && !probe) fx_add(E.ssq_q() + r, s);
                } else if (pn == 3) {
                    LOADV(v, ai, 0, m); float s = 0.f;
#pragma unroll
                    for (int j = 0; j < 8; ++j) s += v[j] * v[j];
                    *(v4u*)(E.CQ() + (size_t)r * 384 + 256 + cw) = pack8(v);
                    s = quad_sum16(s); if (fq == 0 && !probe) fx_add(E.ssq_q() + r, s);
                    if (wc == 0) {
                        LOADV(v, ai, 1, m); rope8(v, E.tab() + (size_t)r * 16, fq);
                        const v4u w = pack8(v); const int b = r >> 12, t = r & 4095;
#pragma unroll
                        for (int h = 0; h < 8; ++h) *(v4u*)(E.Kb() + ((size_t)((b * 8 + h) * SEQ + t)) * 96 + 64 + 8 * fq) = w;
                    }
                } else if (pn == 4) {
                    float s = 0.f;
#pragma unroll
                    for (int bj = 0; bj < 2; ++bj) { LOADV(v, ai, bj, m);
#pragma unroll
                        for (int j = 0; j < 8; ++j) s += v[j] * v[j];
                        *(v4u*)(E.CKV() + (size_t)r * 256 + bj * HALF + cw) = pack8(v); }
                    s = quad_sum16(s); if (fq == 0 && !probe) fx_add(E.ssq_kv() + r, s);
                } else {
#pragma unroll
                    for (int bj = 0; bj < 2; ++bj) { LOADV(v, ai, bj, m); const int col = (pn - 5) * 256 + bj * HALF + cw;
                        const f32x4 b0 = *(const f32x4*)(E.b_gate + col), b1 = *(const f32x4*)(E.b_gate + col + 4);
                        v[0] = sigmoidf_(v[0] + b0[0]); v[1] = sigmoidf_(v[1] + b0[1]); v[2] = sigmoidf_(v[2] + b0[2]); v[3] = sigmoidf_(v[3] + b0[3]);
                        v[4] = sigmoidf_(v[4] + b1[0]); v[5] = sigmoidf_(v[5] + b1[1]); v[6] = sigmoidf_(v[6] + b1[2]); v[7] = sigmoidf_(v[7] + b1[3]);
                        unsigned q[8];
#pragma unroll
                        for (int j = 0; j < 8; ++j) q[j] = (unsigned)(v[j] * 255.0f + 0.5f);
                        *(v2u*)GATE_PTR(gb_, ai, m, bj) = (v2u){q[0] | (q[1] << 8) | (q[2] << 16) | (q[3] << 24), q[4] | (q[5] << 8) | (q[6] << 16) | (q[7] << 24)}; }
                }
            }
    } break;
    case EK_MEMKV: {
#pragma unroll
        for (int ai = 0; ai < 2; ++ai)
#pragma unroll
            for (int m = 0; m < 4; ++m) {
                const int r = rbase + ai * HALF + m * 16, b = r >> 8, key = r & 255;
#pragma unroll
                for (int bj = 0; bj < 2; ++bj) { LOADV(v, ai, bj, m); const int col = u.pn * 256 + bj * HALF + cw, c2 = col & 1023, h = c2 >> 8, d = c2 & 255;
                    *(v4u*)((col < 1024 ? E.KM() : E.VT()) + ((size_t)((h * 8 + b) * 256 + key)) * 256 + d) = pack8(v); }
            }
    } break;
    case EK_Q: {
        constexpr float QS = 0.10206207261596577f * 1.4426950408889634f;
#pragma unroll
        for (int ai = 0; ai < 2; ++ai)
#pragma unroll
            for (int m = 0; m < 4; ++m) {
                const int r = rbase + ai * HALF + m * 16, b = r >> 12, t = r & 4095;
                const float sc = rsqrtf(fx_get(E.ssq_q() + r) * (1.0f / 384.0f) + EPS) * QS;
#pragma unroll
                for (int bj = 0; bj < 2; ++bj) { LOADV(v, ai, bj, m);
#pragma unroll
                    for (int j = 0; j < 8; ++j) v[j] *= sc;
                    if (u.pn < 2) { const int col = u.pn * 256 + bj * HALF + cw, h = col >> 6, d = col & 63;
                        *(v4u*)(E.Qb() + ((size_t)((b * 8 + h) * SEQ + t)) * 96 + d) = pack8(v); }
                    else { const int h = 4 * bj + wc; rope8(v, E.tab() + (size_t)r * 16, fq);
                        *(v4u*)(E.Qb() + ((size_t)((b * 8 + h) * SEQ + t)) * 96 + 64 + 8 * fq) = pack8(v); }
                }
            }
    } break;
    case EK_KV: {
#pragma unroll
        for (int ai = 0; ai < 2; ++ai)
#pragma unroll
            for (int m = 0; m < 4; ++m) {
                const int r = rbase + ai * HALF + m * 16, b = r >> 12, t = r & 4095;
                const float sc = rsqrtf(fx_get(E.ssq_kv() + r) * (1.0f / 256.0f) + EPS);
#pragma unroll
                for (int bj = 0; bj < 2; ++bj) { LOADV(v, ai, bj, m);
#pragma unroll
                    for (int j = 0; j < 8; ++j) v[j] *= sc;
                    const int col = (u.pn & 1) * 256 + bj * HALF + cw, h = col >> 6, d = col & 63;
                    if (u.pn < 2) *(v4u*)(E.Kb() + ((size_t)((b * 8 + h) * SEQ + t)) * 96 + d) = pack8(v);
                    else *(v4u*)(E.Vb() + ((size_t)((b * 8 + h) * SEQ + t)) * 64 + d) = pack8(v);
                }
            }
    } break;
    case EK_Y: {
#pragma unroll
        for (int ai = 0; ai < 2; ++ai)
#pragma unroll
            for (int m = 0; m < 4; ++m) {
                const int r = rbase + ai * HALF + m * 16;
#pragma unroll
                for (int bj = 0; bj < 2; ++bj) { LOADV(v, ai, bj, m);
#pragma unroll
                    for (int j = 0; j < 8; ++j) v[j] = gelu_tanh(v[j]);
                    const int col = u.pn * 256 + bj * HALF + cw, t = col >> 4, c0 = col & 15;
                    *(v4u*)(E.YS() + ((size_t)(r * TCH + t)) * 512 + u.z * 16 + c0) = pack8(v); }
            }
    } break;
    case EK_P4: {
        const unsigned char* const gb_ = (const unsigned char*)GATE_BASE(u.pm, u.z == 0 ? (u.pn >> 1) : 4 + u.pn);
        unsigned char* const sb0_ = GS_BASE(u.pm, u.z == 0 ? u.pn : 2 * u.pn); unsigned char* const sb1_ = GS_BASE(u.pm, u.z == 0 ? u.pn : 2 * u.pn + 1);
#pragma unroll
        for (int ai = 0; ai < 2; ++ai)
#pragma unroll
            for (int m = 0; m < 4; ++m) {
                const int r = rbase + ai * HALF + m * 16;
                if (u.z == 0) {
                    float a[8], gt[8]; LOADV(a, ai, 0, m); LOADV(gt, ai, 1, m);
                    const int col = u.pn * 128 + cw;
                    const v2u gw = *(const v2u*)GATE_PTR(gb_, ai, m, u.pn & 1); constexpr float I255 = 1.0f / 255.0f;
                    const float gs[8] = {(float)(gw.x & 255u) * I255, (float)((gw.x >> 8) & 255u) * I255, (float)((gw.x >> 16) & 255u) * I255, (float)(gw.x >> 24) * I255,
                                         (float)(gw.y & 255u) * I255, (float)((gw.y >> 8) & 255u) * I255, (float)((gw.y >> 16) & 255u) * I255, (float)(gw.y >> 24) * I255};
#pragma unroll
                    for (int j = 0; j < 8; ++j) v[j] = a[j] * sigmoidf_(gt[j]) * gs[j];
                    *(v4u*)GS_PTR(sb0_, ai, m) = pack8(v);
                } else {
#pragma unroll
                    for (int bj = 0; bj < 2; ++bj) { LOADV(v, ai, bj, m); const int col = u.pn * 256 + bj * HALF + cw;
                        const v2u gw = *(const v2u*)GATE_PTR(gb_, ai, m, bj); constexpr float I255 = 1.0f / 255.0f;
                        const v4u sw = *(const v4u*)GS_PTR(bj ? sb1_ : sb0_, ai, m);
                        v[0] = v[0] * ((float)(gw.x & 255u) * I255) + bf_lo(sw.x); v[1] = v[1] * ((float)((gw.x >> 8) & 255u) * I255) + bf_hi(sw.x);
                        v[2] = v[2] * ((float)((gw.x >> 16) & 255u) * I255) + bf_lo(sw.y); v[3] = v[3] * ((float)(gw.x >> 24) * I255) + bf_hi(sw.y);
                        v[4] = v[4] * ((float)(gw.y & 255u) * I255) + bf_lo(sw.z); v[5] = v[5] * ((float)((gw.y >> 8) & 255u) * I255) + bf_hi(sw.z);
                        v[6] = v[6] * ((float)((gw.y >> 16) & 255u) * I255) + bf_lo(sw.w); v[7] = v[7] * ((float)(gw.y >> 24) * I255) + bf_hi(sw.w);
                        *(v4u*)(E.MERGED() + (size_t)r * 1024 + col) = pack8(v); }
                }
            }
    } break;
    case EK_OUT: case EK_MO: {
        u64* ssq = (g.epi == EK_OUT) ? E.ssq1() : E.ssq2();
#pragma unroll
        for (int ai = 0; ai < 2; ++ai)
#pragma unroll
            for (int m = 0; m < 4; ++m) {
                const int r = rbase + ai * HALF + m * 16; float s = 0.f;
                float qs = 0.f; if (g.epi == EK_MO) qs = H8_SCALE * rsqrtf(fx_get(E.ssq1() + r) * (1.0f / 1024.0f) + EPS);
#pragma unroll
                for (int bj = 0; bj < 2; ++bj) { LOADV(v, ai, bj, m); const int col = u.pn * 256 + bj * HALF + cw;
                    if (g.epi == EK_OUT) { const f32x4 x0 = *(const f32x4*)(E.x + (size_t)r * 1024 + col), x1 = *(const f32x4*)(E.x + (size_t)r * 1024 + col + 4);
                        v[0] += x0[0]; v[1] += x0[1]; v[2] += x0[2]; v[3] += x0[3]; v[4] += x1[0]; v[5] += x1[1]; v[6] += x1[2]; v[7] += x1[3]; }
                    else { const v4u hw = *(const v4u*)(E.HB() + (size_t)r * 1024 + col);
                        v[0] += bf_lo(hw.x); v[1] += bf_hi(hw.x); v[2] += bf_lo(hw.y); v[3] += bf_hi(hw.y); v[4] += bf_lo(hw.z); v[5] += bf_hi(hw.z); v[6] += bf_lo(hw.w); v[7] += bf_hi(hw.w); }
#pragma unroll
                    for (int j = 0; j < 8; ++j) s += v[j] * v[j];
                    *(v4u*)((probe ? (bf16*)E.H() : E.HB()) + (size_t)r * 1024 + col) = pack8(v);
                    if (g.epi == EK_MO && !probe) {
                        unsigned w0 = 0u, w1 = 0u;
#pragma unroll
                        for (int j = 0; j < 4; ++j) { w0 = __builtin_amdgcn_cvt_pk_u8_f32(__builtin_amdgcn_fmed3f(__builtin_rintf(__builtin_fmaf(v[j], qs, 128.0f)), 1.0f, 255.0f), j, w0);
                                                      w1 = __builtin_amdgcn_cvt_pk_u8_f32(__builtin_amdgcn_fmed3f(__builtin_rintf(__builtin_fmaf(v[4 + j], qs, 128.0f)), 1.0f, 255.0f), j, w1); }
                        *(v2u*)(E.H8() + (size_t)r * 1024 + col) = (v2u){w0 ^ 0x80808080u, w1 ^ 0x80808080u}; } }
                s = quad_sum16(s); if (fq == 0 && !probe) fx_add(ssq + r, s);
            }
    } break;
    case EK_W1: case EK_W2: case EK_W3: {
#pragma unroll
        for (int ai = 0; ai < 2; ++ai)
#pragma unroll
            for (int m = 0; m < 4; ++m) {
                const int r = rbase + ai * HALF + m * 16;
#pragma unroll
                for (int bj = 0; bj < 2; ++bj) { LOADV(v, ai, bj, m); const int col = u.pn * 256 + bj * HALF + cw;
                    bf16* p;
                    if (g.epi == EK_W1) p = E.W1() + ((size_t)(u.z * 256 + r)) * 1024 + col;
                    else if (g.epi == EK_W2) p = E.W2() + ((size_t)((r >> 8) * 1024 + u.z * 256 + (r & 255))) * 1024 + col;
                    else p = E.W3() + ((size_t)(u.pn * 1024 + r)) * 1024 + u.z * 256 + (col & 255);
                    *(v4u*)p = pack8(v); }
            }
    } break;
    case EK_PS2: {
#pragma unroll
        for (int ai = 0; ai < 2; ++ai)
#pragma unroll
            for (int m = 0; m < 4; ++m) {
                const int r = rbase + ai * HALF + m * 16;
#pragma unroll
                for (int bj = 0; bj < 2; ++bj) { LOADV(v, ai, bj, m);
                    const v4u ow = {pkh2(v[0], v[1]), pkh2(v[2], v[3]), pkh2(v[4], v[5]), pkh2(v[6], v[7])};
                    *(v4u*)(E.SC() + (size_t)r * 2048 + u.pn * 256 + bj * HALF + cw) = ow; }
            }
    } break;
    default: break;
    }
}

__device__ __forceinline__ void epilogue_ms2(const EpiArgs& E, Acc& acc, const Unit& u, int wr, int wc, int fr, int fq, PG8_LAS float* xch) {
    const int rbase = u.pm * BM + wr * 64 + fr, cw = wc * 32 + 8 * fq;
#pragma unroll
    for (int ai = 0; ai < 2; ++ai)
#pragma unroll
        for (int m = 0; m < 4; ++m) {
            const int r = rbase + ai * HALF + m * 16;
            const float sc = rsqrtf(fx_get(E.ssq1() + r) * (1.0f / 1024.0f) + EPS) * (0.0625f * 1.4426950408889634f);
            float s = 0.f;
#pragma unroll
            for (int bj = 0; bj < 2; ++bj)
#pragma unroll
                for (int n = 0; n < 2; ++n) { f32x4 t = acc[ai][bj][m][n];
                    t[0] = __builtin_amdgcn_exp2f(fminf(t[0] * sc, 100.f)); t[1] = __builtin_amdgcn_exp2f(fminf(t[1] * sc, 100.f)); t[2] = __builtin_amdgcn_exp2f(fminf(t[2] * sc, 100.f)); t[3] = __builtin_amdgcn_exp2f(fminf(t[3] * sc, 100.f));
                    s += (t[0] + t[1]) + (t[2] + t[3]); acc[ai][bj][m][n] = t; }
            s = quad_sum16(s);
            if (fq == 0) xch[(ai * HALF + wr * 64 + m * 16 + fr) * 4 + wc] = s;
        }
    asm volatile("s_waitcnt lgkmcnt(0)" ::: "memory"); __builtin_amdgcn_s_barrier(); asm volatile("" ::: "memory");
    float v[8];
#pragma unroll
    for (int ai = 0; ai < 2; ++ai)
#pragma unroll
        for (int m = 0; m < 4; ++m) {
            const int r = rbase + ai * HALF + m * 16;
            const f32x4 ps = *(const PG8_LAS f32x4*)(xch + (ai * HALF + wr * 64 + m * 16 + fr) * 4);
            const float inv = __builtin_amdgcn_rcpf((ps[0] + ps[1]) + (ps[2] + ps[3]));
#pragma unroll
            for (int bj = 0; bj < 2; ++bj) { LOADV(v, ai, bj, m);
#pragma unroll
                for (int j = 0; j < 8; ++j) v[j] *= inv;
                *(v4u*)(E.PM() + (size_t)r * 1024 + u.pn * 256 + bj * HALF + cw) = pack8(v); }
        }
}

__device__ __forceinline__ void epilogue_sloc(const EpiArgs& E, const Acc& acc, const Unit& u, int wr, int wc, int fr, int fq) {
    const int rbase = u.pm * BM + wr * 64 + fr, cw = wc * 32 + 8 * fq, g = u.z;
    float v[8];
#pragma unroll
    for (int ai = 0; ai < 2; ++ai)
#pragma unroll
        for (int m = 0; m < 4; ++m) {
            const int r = rbase + ai * HALF + m * 16;
#pragma unroll
            for (int bj = 0; bj < 2; ++bj) { LOADV(v, ai, bj, m); float* p = E.SLOC() + ((size_t)(g * NCHUNK + r)) * 256 + bj * HALF + cw;
                *(f32x4*)p = (f32x4){v[0], v[1], v[2], v[3]}; *(f32x4*)(p + 4) = (f32x4){v[4], v[5], v[6], v[7]}; }
        }
    asm volatile("s_waitcnt vmcnt(0)" ::: "memory");
    __syncthreads();
    int tid = threadIdx.x; asm volatile("" : "+v"(tid));
    if (tid < 256) {
        const int bl = tid >> 7, dir = (tid >> 6) & 1, p = tid & 63;
        const int pi = (dir * 32 + g) * 64 + p;
        const float dt = __expf(E.log_dt[dir * 32 + g]);
        const float lr = E.lam_re[pi], li = E.lam_im[pi];
        const float mag = __expf((float)TCH * lr * dt); float sn, cs; sincos_rev((float)TCH * li * dt, sn, cs);
        const float Ar = mag * cs, Ai = mag * sn;
        const int row0 = u.pm * BM + bl * 128;
        const unsigned long long* S = (const unsigned long long*)(E.SLOC() + ((size_t)(g * NCHUNK + row0)) * 256 + dir * 128 + p * 2);
        bf16* C = E.U() + ((size_t)(g * NCHUNK + row0)) * UPITCH + 512 + dir * 128 + p * 2;
        float fr_ = 0.f, fi_ = 0.f;
        for (int n0 = 0; n0 < 128; n0 += 16) {
            unsigned long long sv[16];
#pragma unroll
            for (int k = 0; k < 16; ++k) { const int n = dir ? (127 - (n0 + k)) : (n0 + k); sv[k] = __hip_atomic_load(S + (size_t)n * 128, RLX_AGENT); }
#pragma unroll
            for (int k = 0; k < 16; ++k) { const int n = dir ? (127 - (n0 + k)) : (n0 + k);
                *(unsigned*)(C + (size_t)n * UPITCH) = pk2(fr_, fi_);
                const float sr = __builtin_bit_cast(float, (unsigned)sv[k]), si = __builtin_bit_cast(float, (unsigned)(sv[k] >> 32));
                const float nr = Ar * fr_ - Ai * fi_ + sr, ni = Ar * fi_ + Ai * fr_ + si; fr_ = nr; fi_ = ni; }
        }
    }
}

template <bool DUMMY = true>
__device__ __forceinline__ void gemm_phase(PG8_LAS unsigned char* lds, const GemmDesc& g, const EpiArgs& E, int G, int c, int mode = 0) {
    const bool dry = (mode == 1);
    int tid_ = threadIdx.x; asm volatile("" : "+v"(tid_));
    const int tid = tid_, wid = __builtin_amdgcn_readfirstlane(tid >> 6), lane = tid & 63, wr = wid >> 2, wc = wid & 3, fr = lane & 15, fq = lane >> 4;
    const int K = g.K, nt = K / BK, lda = g.lda, ldb = g.ldb;
    unsigned voffA[2], voffB[2];
#pragma unroll
    for (int i = 0; i < 2; ++i) { int R, C; stage_rc(tid * 16 + i * 8192, R, C); const int Rb = (R & ~31) + perm32(R & 31);
        voffA[i] = (unsigned)(R * lda + C) * 2u; voffB[i] = (unsigned)(Rb * ldb + C) * 2u; }
    const size_t kstep = (size_t)(BK * 2);
    const size_t hA = (size_t)HALF * lda * 2, hB = (size_t)HALF * ldb * 2;
    const unsigned ldsw = (unsigned)wid * 1024u;
    const int aoff = lds_byte(wr * 64 + fr, fq * 8), boff = lds_byte(wc * 32 + fr, fq * 8);
#define PG8_SA(b, h) (((b) * 2 + (h)) * HTB)
#define PG8_SB(b, h) ((4 + (b) * 2 + (h)) * HTB)
#define PG8_STAGE(bufoff, gbase, voff) do { _Pragma("unroll") for (int _i = 0; _i < 2; ++_i) \
        __builtin_amdgcn_global_load_lds((const unsigned*)((const char*)(gbase) + (voff)[_i]), (PG8_LAS unsigned*)(lds + (bufoff) + ldsw + _i * 8192), 16, 0, 0); } while (0)
#define PG8_LDA(dst, b, h) do { _Pragma("unroll") for (int m = 0; m < 4; ++m) _Pragma("unroll") for (int k = 0; k < 2; ++k) dst[m][k] = *(const PG8_LAS bf16x8*)(lds + PG8_SA(b, h) + aoff + m * 2048 + k * 1024); } while (0)
#define PG8_LDB(dst, b, h) do { _Pragma("unroll") for (int n = 0; n < 2; ++n) _Pragma("unroll") for (int k = 0; k < 2; ++k) dst[n][k] = *(const PG8_LAS bf16x8*)(lds + PG8_SB(b, h) + boff + n * 2048 + k * 1024); } while (0)
#define PG8_MMA(ai, bj, At, Bt) do { __builtin_amdgcn_s_setprio(1); _Pragma("unroll") for (int m = 0; m < 4; ++m) _Pragma("unroll") for (int n = 0; n < 2; ++n) _Pragma("unroll") for (int k = 0; k < 2; ++k) \
        acc[ai][bj][m][n] = __builtin_amdgcn_mfma_f32_16x16x32_bf16(Bt[n][k], At[m][k], acc[ai][bj][m][n], 0, 0, 0); __builtin_amdgcn_s_setprio(0); } while (0)
#define PG8_WAIT_V(n) asm volatile("s_waitcnt vmcnt(" #n ")" ::: "memory")
#define PG8_WAIT_L(n) asm volatile("s_waitcnt lgkmcnt(" #n ")" ::: "memory")
#define PG8_BAR __builtin_amdgcn_s_barrier()
#define PG8_SCHED __builtin_amdgcn_sched_barrier(0)
    Unit cur, nxt; int ui = 0;
    if (!g.next(0, G, c, cur)) return;
    Acc acc;
#pragma unroll
    for (int a = 0; a < 2; ++a)
#pragma unroll
        for (int b = 0; b < 2; ++b)
#pragma unroll
            for (int m = 0; m < 4; ++m)
#pragma unroll
                for (int n = 0; n < 2; ++n) acc[a][b][m][n] = (f32x4){0.f, 0.f, 0.f, 0.f};
    bf16x8 At[4][2], B0[2][2], B1[2][2];
    const char* cA = g.aptr(cur); const char* cB = g.bptr(cur);
    PG8_STAGE(PG8_SB(0, 0), cB, voffB); PG8_STAGE(PG8_SB(0, 1), cB + hB, voffB); PG8_STAGE(PG8_SA(0, 0), cA, voffA); PG8_STAGE(PG8_SA(0, 1), cA + hA, voffA);
    if (wr == 1) PG8_BAR;
    PG8_WAIT_V(2); PG8_BAR;
    PG8_STAGE(PG8_SB(1, 0), cB + kstep, voffB); PG8_STAGE(PG8_SA(1, 0), cA + kstep, voffA); PG8_STAGE(PG8_SB(1, 1), cB + hB + kstep, voffB);
    PG8_WAIT_V(6); PG8_BAR;
    for (;;) {
        const bool has_next = g.next(ui + 1, G, c, nxt);
        const char* nA = has_next ? g.aptr(nxt) : cA; const char* nB = has_next ? g.bptr(nxt) : cB;
        for (int t = 0; t < nt; t += 2) {
            const bool last = (t == nt - 2);
            const char* a1 = cA + (size_t)(t + 1) * kstep;
            const char* a2 = last ? nA : cA + (size_t)(t + 2) * kstep; const char* b2 = last ? nB : cB + (size_t)(t + 2) * kstep;
            const char* a3 = a2 + kstep; const char* b3 = b2 + kstep;
            PG8_LDB(B0, 0, 0); PG8_LDB(B1, 0, 1); PG8_SCHED; PG8_LDA(At, 0, 0); PG8_STAGE(PG8_SA(1, 1), a1 + hA, voffA);
            PG8_WAIT_V(8); PG8_WAIT_L(0); PG8_BAR; PG8_MMA(0, 0, At, B0); PG8_MMA(0, 1, At, B1); PG8_BAR; PG8_SCHED;
            PG8_LDA(At, 0, 1); PG8_STAGE(PG8_SB(0, 0), b2, voffB); PG8_STAGE(PG8_SB(0, 1), b2 + hB, voffB); PG8_STAGE(PG8_SA(0, 0), a2, voffA);
            PG8_WAIT_V(8); PG8_WAIT_L(0); PG8_BAR; PG8_MMA(1, 0, At, B0); PG8_MMA(1, 1, At, B1); PG8_BAR; PG8_SCHED;
            PG8_LDB(B0, 1, 0); PG8_LDB(B1, 1, 1); PG8_SCHED; PG8_LDA(At, 1, 0); PG8_STAGE(PG8_SA(0, 1), a2 + hA, voffA);
            PG8_WAIT_V(8); PG8_WAIT_L(0); PG8_BAR; PG8_MMA(0, 0, At, B0); PG8_MMA(0, 1, At, B1); PG8_BAR; PG8_SCHED;
            PG8_LDA(At, 1, 1); PG8_STAGE(PG8_SB(1, 0), b3, voffB); PG8_STAGE(PG8_SB(1, 1), b3 + hB, voffB); PG8_STAGE(PG8_SA(1, 0), a3, voffA);
            PG8_WAIT_V(8); PG8_WAIT_L(0); PG8_BAR; PG8_MMA(1, 0, At, B0); PG8_MMA(1, 1, At, B1); PG8_BAR; PG8_SCHED;
        }
        if (wr == 0) PG8_BAR;
        if (!g.after_drain && !dry) { if (g.epi == EK_MS2) epilogue_ms2(E, acc, cur, wr, wc, fr, fq, (PG8_LAS float*)(lds + XCH_OFF_) + (ui & 1) * 1024); else epilogue(g, E, acc, cur, wr, wc, fr, fq, mode == 2); }
        if (dry) { _Pragma("unroll") for (int a = 0; a < 2; ++a) _Pragma("unroll") for (int b = 0; b < 2; ++b) _Pragma("unroll") for (int m = 0; m < 4; ++m) _Pragma("unroll") for (int n = 0; n < 2; ++n) asm volatile("" :: "v"(acc[a][b][m][n])); }
        if (!has_next) break;
#pragma unroll
        for (int a = 0; a < 2; ++a)
#pragma unroll
            for (int b = 0; b < 2; ++b)
#pragma unroll
                for (int m = 0; m < 4; ++m)
#pragma unroll
                    for (int n = 0; n < 2; ++n) acc[a][b][m][n] = (f32x4){0.f, 0.f, 0.f, 0.f};
        cur = nxt; cA = nA; cB = nB; ++ui;
        if (wr == 1) PG8_BAR;
    }
    PG8_WAIT_V(0);
    PG8_BAR;
    if (g.after_drain && !dry) epilogue_sloc(E, acc, cur, wr, wc, fr, fq);
#undef PG8_SA
#undef PG8_SB
#undef PG8_STAGE
#undef PG8_LDA
#undef PG8_LDB
#undef PG8_MMA
#undef PG8_WAIT_V
#undef PG8_WAIT_L
#undef PG8_BAR
#undef PG8_SCHED
}
}

namespace att {
using s16x4  = __attribute__((ext_vector_type(4))) short;
using f32x16 = __attribute__((ext_vector_type(16))) float;
constexpr int DQK = 96, DV = 64, NW = 8, QBLK = 32, KVBLK = 64;
constexpr int KPITCH = DQK * 2 + 16;
constexpr int SHM_K = KVBLK * KPITCH, SHM_V = KVBLK * DV * 2;
constexpr int NBUF = 3;
constexpr int OFF_V = 0, OFF_K = NBUF * SHM_V, OFF_WS = OFF_K + NBUF * SHM_K, OFF_OST = 69632, OST_BYTES = 6144;
static_assert(OFF_WS + 8 * 64 * 4 <= OFF_OST && OFF_OST + 8 * OST_BYTES <= 131072, "attention LDS map");
constexpr float THRL = 8.0f;
#define SBAR() __builtin_amdgcn_sched_barrier(0)
__device__ __forceinline__ int crow(int r, int hi) { return (r & 3) + 8 * (r >> 2) + 4 * hi; }
__device__ __forceinline__ unsigned cvtpk(float lo, float hi) { unsigned r; asm("v_cvt_pk_bf16_f32 %0, %1, %2" : "=v"(r) : "v"(lo), "v"(hi)); return r; }
__device__ __forceinline__ float max3f(float a, float b, float c) { return __builtin_fmaxf(__builtin_fmaxf(a, b), c); }
template <bool FIRST>
__device__ __forceinline__ void partialSM(f32x16& p0, f32x16& p1, float& m_reg, f32x16& negm, float& alpha) {
    float a = max3f(p0[0], p0[1], p1[0]), b = max3f(p0[2], p0[3], p1[1]); a = max3f(a, p1[2], p1[3]);
#pragma unroll
    for (int r = 4; r < 16; r += 4) { a = max3f(a, p0[r], p0[r + 1]); b = max3f(b, p0[r + 2], p0[r + 3]); a = max3f(a, p1[r], p1[r + 1]); b = max3f(b, p1[r + 2], p1[r + 3]); }
    float pmax = fmaxf(a, b);
    { auto rr = __builtin_amdgcn_permlane32_swap(__float_as_uint(pmax), __float_as_uint(pmax), false, false);
      pmax = fmaxf(__uint_as_float(rr[0]), __uint_as_float(rr[1])); }
    alpha = 1.f;
    if (FIRST || !__builtin_expect(__all(pmax <= THRL), 1)) {
        const float d = FIRST ? pmax : fmaxf(pmax, 0.f);
        m_reg += d; if (!FIRST) alpha = __builtin_amdgcn_exp2f(-d);
#pragma unroll
        for (int r = 0; r < 16; ++r) { p0[r] -= d; p1[r] -= d; }
#pragma unroll
        for (int r = 0; r < 16; ++r) negm[r] = -m_reg;
    }
#pragma unroll
    for (int r = 0; r < 16; ++r) p0[r] = __builtin_amdgcn_exp2f(p0[r]);
}
__device__ __forceinline__ void finishSM(f32x16& p0, f32x16& p1, float alpha, float& l_reg, bf16x8& pa0, bf16x8& pa1, bf16x8& pa2, bf16x8& pa3) {
#pragma unroll
    for (int r = 0; r < 16; ++r) p1[r] = __builtin_amdgcn_exp2f(p1[r]);
    float ps0 = p0[0], ps1 = p0[1], ps2 = p0[2], ps3 = p0[3];
#pragma unroll
    for (int r = 4; r < 16; r += 4) { ps0 += p0[r]; ps1 += p0[r + 1]; ps2 += p0[r + 2]; ps3 += p0[r + 3]; }
#pragma unroll
    for (int r = 0; r < 16; r += 4) { ps0 += p1[r]; ps1 += p1[r + 1]; ps2 += p1[r + 2]; ps3 += p1[r + 3]; }
    float ps = (ps0 + ps1) + (ps2 + ps3);
    { auto rr = __builtin_amdgcn_permlane32_swap(__float_as_uint(ps), __float_as_uint(ps), false, false);
      ps = __uint_as_float(rr[0]) + __uint_as_float(rr[1]); }
    l_reg = l_reg * alpha + ps;
#define PK4(P, BASE, OUT) do { unsigned a0 = cvtpk(P[BASE + 0], P[BASE + 1]), a1 = cvtpk(P[BASE + 2], P[BASE + 3]);   \
    unsigned b0 = cvtpk(P[BASE + 4], P[BASE + 5]), b1 = cvtpk(P[BASE + 6], P[BASE + 7]);                              \
    auto r0 = __builtin_amdgcn_permlane32_swap(a0, b0, false, false); auto r1 = __builtin_amdgcn_permlane32_swap(a1, b1, false, false); \
    v4u w = {r0[0], r1[0], r0[1], r1[1]}; OUT = *reinterpret_cast<bf16x8*>(&w); } while (0)
    PK4(p0, 0, pa0); PK4(p0, 8, pa1); PK4(p1, 0, pa2); PK4(p1, 8, pa3);
#undef PK4
}
__device__ __forceinline__ void qkt(f32x16& p0, f32x16& p1, const char* Ks, const bf16x8* qr, const f32x16& negm, int r32, int hi) {
#pragma unroll
    for (int d0 = 0; d0 < DQK / 16; ++d0) { const int cb = (d0 * 16 + hi * 8) * 2;
        const bf16x8 b0 = *reinterpret_cast<const bf16x8*>(Ks + r32 * KPITCH + cb);
        const bf16x8 b1 = *reinterpret_cast<const bf16x8*>(Ks + (32 + r32) * KPITCH + cb);
        if (d0 == 0) { p0 = __builtin_amdgcn_mfma_f32_32x32x16_bf16(b0, qr[0], negm, 0, 0, 0); p1 = __builtin_amdgcn_mfma_f32_32x32x16_bf16(b1, qr[0], negm, 0, 0, 0); }
        else { p0 = __builtin_amdgcn_mfma_f32_32x32x16_bf16(b0, qr[d0], p0, 0, 0, 0); p1 = __builtin_amdgcn_mfma_f32_32x32x16_bf16(b1, qr[d0], p1, 0, 0, 0); } }
}
__device__ __forceinline__ int v_st(int k, int c) { const int kk = (k & ~0xC) | ((k & 4) << 1) | ((k & 8) >> 1); return ((kk >> 3) * 2 + (c >> 5)) * 512 + ((kk & 7) * 32 + (c & 31)) * 2; }
__device__ __forceinline__ int v_rd_base(int lane) { return ((lane & 3) << 3) | (((lane >> 2) & 3) << 6) | (((lane >> 4) & 1) << 5) | (((lane >> 5) & 1) << 8); }
constexpr int v_rd_off(int d0, int ks, int half) { return d0 * 512 + ks * 2048 + half * 1024; }
template <int OFF> __device__ __forceinline__ s16x4 tr_read(int vb) {
    s16x4 r; asm volatile("ds_read_b64_tr_b16 %0, %1 offset:%2" : "=&v"(r) : "v"(vb), "i"(OFF) : "memory"); return r;
}
template <int D0> __device__ __forceinline__ void pv_one(f32x16& od, int vb, bf16x8 pa0, bf16x8 pa1, bf16x8 pa2, bf16x8 pa3) {
    const s16x4 l0 = tr_read<v_rd_off(D0, 0, 0)>(vb), h0 = tr_read<v_rd_off(D0, 0, 1)>(vb), l1 = tr_read<v_rd_off(D0, 1, 0)>(vb), h1 = tr_read<v_rd_off(D0, 1, 1)>(vb);
    const s16x4 l2 = tr_read<v_rd_off(D0, 2, 0)>(vb), h2 = tr_read<v_rd_off(D0, 2, 1)>(vb), l3 = tr_read<v_rd_off(D0, 3, 0)>(vb), h3 = tr_read<v_rd_off(D0, 3, 1)>(vb);
    asm volatile("s_waitcnt lgkmcnt(0)" ::: "memory"); SBAR();
#define PK(L, H) (bf16x8){L[0], L[1], L[2], L[3], H[0], H[1], H[2], H[3]}
    od = __builtin_amdgcn_mfma_f32_32x32x16_bf16(pa0, PK(l0, h0), od, 0, 0, 0);
    od = __builtin_amdgcn_mfma_f32_32x32x16_bf16(pa1, PK(l1, h1), od, 0, 0, 0);
    od = __builtin_amdgcn_mfma_f32_32x32x16_bf16(pa2, PK(l2, h2), od, 0, 0, 0);
    od = __builtin_amdgcn_mfma_f32_32x32x16_bf16(pa3, PK(l3, h3), od, 0, 0, 0);
#undef PK
}
__device__ __forceinline__ void pv_d0(f32x16* o, int vb, bf16x8 pa0, bf16x8 pa1, bf16x8 pa2, bf16x8 pa3) {
    pv_one<0>(o[0], vb, pa0, pa1, pa2, pa3); pv_one<1>(o[1], vb, pa0, pa1, pa2, pa3);
}
__device__ __forceinline__ void attn_unit(const bf16* __restrict__ Qb, const bf16* __restrict__ Kh, const bf16* __restrict__ Vh, bf16* __restrict__ Ob, char* lds) {
    int tid_ = threadIdx.x; asm volatile("" : "+v"(tid_));
    const int tid = tid_, wid = tid >> 6, lane = tid & 63, r32 = lane & 31, hi = lane >> 5;
    char* V_lds = lds + OFF_V; char* K_lds = lds + OFF_K;
    float* ws = (float*)(lds + OFF_WS) + wid * 64; float* li_l = ws; float* al_l = ws + 32;
    float m_reg = 0.f, l_reg = 0; f32x16 o[2] = {}; bf16x8 qr[DQK / 16]; f32x16 negm = {};
    { char* qst = lds + OFF_OST + wid * OST_BYTES; const char* Qg = (const char*)(Qb + (long)(wid * QBLK) * DQK);
      v4u qv[6];
#pragma unroll
      for (int i = 0; i < 6; ++i) qv[i] = *(const v4u*)(Qg + i * 1024 + lane * 16);
#pragma unroll
      for (int i = 0; i < 6; ++i) *(v4u*)(qst + i * 1024 + lane * 16) = qv[i];
      asm volatile("s_waitcnt lgkmcnt(0)" ::: "memory");
#pragma unroll
      for (int d0 = 0; d0 < DQK / 16; ++d0) qr[d0] = *reinterpret_cast<const bf16x8*>(qst + r32 * (DQK * 2) + (d0 * 16 + hi * 8) * 2);
      asm volatile("s_waitcnt lgkmcnt(0)" ::: "memory"); }
    const int kc0 = tid, kc1 = 512 + (tid & 255);
    const int kd0 = (kc0 / 12) * KPITCH + (kc0 % 12) * 16, kd1 = (kc1 / 12) * KPITCH + (kc1 % 12) * 16;
    const int vd0 = v_st(tid >> 3, (tid & 7) * 8);
    const int vb0 = (int)(uintptr_t)V_lds + v_rd_base(lane);
    const bool k1w = (__builtin_amdgcn_readfirstlane(tid) < 256);
    if (!k1w) __builtin_amdgcn_s_setprio(1);
    struct { bf16x8 vs0, ks0, ks1; } sr_[2];
#define SLOAD(i, k0) do { const char* kb_ = (const char*)(Kh + (long)(k0) * DQK); const char* vb_ = (const char*)(Vh + (long)(k0) * DV); \
    sr_[i].vs0 = *reinterpret_cast<const bf16x8*>(vb_ + tid * 16); sr_[i].ks0 = *reinterpret_cast<const bf16x8*>(kb_ + kc0 * 16); sr_[i].ks1 = *reinterpret_cast<const bf16x8*>(kb_ + kc1 * 16); } while (0)
#define SWRITE(slot, i) do { *(bf16x8*)(V_lds + (slot) * SHM_V + vd0) = sr_[i].vs0; *(bf16x8*)(K_lds + (slot) * SHM_K + kd0) = sr_[i].ks0; \
    if (k1w) *(bf16x8*)(K_lds + (slot) * SHM_K + kd1) = sr_[i].ks1; } while (0)
#define RESC(a) do { if (__any((a) < 1.f)) { if (hi == 0) al_l[r32] = (a); asm volatile("s_waitcnt lgkmcnt(0)" ::: "memory"); \
    _Pragma("unroll") for (int d = 0; d < 2; ++d) _Pragma("unroll") for (int r = 0; r < 16; ++r) o[d][r] *= al_l[crow(r, hi)]; } } while (0)
#define NEXT3(s) ((s) == 2 ? 0 : (s) + 1)
    f32x16 pA0, pA1, pB0, pB1; float alA, alB; bf16x8 pa0, pa1, pa2, pa3; constexpr int NT = SEQ / KVBLK;
    SLOAD(0, 0); asm volatile("s_waitcnt vmcnt(0)" ::: "memory"); SWRITE(0, 0);
    SLOAD(1, KVBLK); SLOAD(0, 2 * KVBLK);
    __syncthreads();
    qkt(pA0, pA1, K_lds, qr, negm, r32, hi); partialSM<true>(pA0, pA1, m_reg, negm, alA);
    SWRITE(1, 1);
    __syncthreads();
    int sk = 1, sv = 0;
    for (int j = 1; j + 1 < NT; j += 2) {
        SBAR(); __builtin_amdgcn_s_setprio(2); qkt(pB0, pB1, K_lds + sk * SHM_K, qr, negm, r32, hi);
        finishSM(pA0, pA1, alA, l_reg, pa0, pa1, pa2, pa3); if (k1w) __builtin_amdgcn_s_setprio(0); else __builtin_amdgcn_s_setprio(1); SBAR();
        SLOAD(1, (j + 2) * KVBLK); SBAR();
        pv_d0(o, vb0 + sv * SHM_V, pa0, pa1, pa2, pa3); partialSM<false>(pB0, pB1, m_reg, negm, alB);
        { const int sw = NEXT3(sk); SWRITE(sw, 0); }
        RESC(alB); __syncthreads();
        sv = sk; sk = NEXT3(sk);
        SBAR(); __builtin_amdgcn_s_setprio(2); qkt(pA0, pA1, K_lds + sk * SHM_K, qr, negm, r32, hi);
        finishSM(pB0, pB1, alB, l_reg, pa0, pa1, pa2, pa3); if (k1w) __builtin_amdgcn_s_setprio(0); else __builtin_amdgcn_s_setprio(1); SBAR();
        SLOAD(0, (j + 3 < NT ? j + 3 : NT - 1) * KVBLK); SBAR();
        pv_d0(o, vb0 + sv * SHM_V, pa0, pa1, pa2, pa3); partialSM<false>(pA0, pA1, m_reg, negm, alA);
        { const int sw = NEXT3(sk); SWRITE(sw, 1); }
        RESC(alA); __syncthreads();
        sv = sk; sk = NEXT3(sk);
    }
    SBAR(); qkt(pB0, pB1, K_lds + sk * SHM_K, qr, negm, r32, hi);
    finishSM(pA0, pA1, alA, l_reg, pa0, pa1, pa2, pa3); SBAR();
    pv_d0(o, vb0 + sv * SHM_V, pa0, pa1, pa2, pa3); partialSM<false>(pB0, pB1, m_reg, negm, alB);
    RESC(alB);
    finishSM(pB0, pB1, alB, l_reg, pa0, pa1, pa2, pa3); SBAR();
    pv_d0(o, vb0 + sk * SHM_V, pa0, pa1, pa2, pa3);
    if (hi == 0) li_l[r32] = l_reg; asm volatile("s_waitcnt lgkmcnt(0)" ::: "memory");
    float rli[16];
#pragma unroll
    for (int r = 0; r < 16; ++r) rli[r] = __builtin_amdgcn_rcpf(li_l[crow(r, hi)]);
    { char* ost = lds + OFF_OST + wid * OST_BYTES;
#pragma unroll
      for (int r = 0; r < 16; ++r) { const int orow = crow(r, hi);
#pragma unroll
          for (int d0 = 0; d0 < 2; ++d0) *(bf16*)(ost + orow * 128 + (d0 * 32 + r32) * 2) = (bf16)f2bf(o[d0][r] * rli[r]); }
      asm volatile("s_waitcnt lgkmcnt(0)" ::: "memory");
      bf16* Ow = Ob + (long)(wid * QBLK) * 512;
#pragma unroll
      for (int q = 0; q < 4; ++q) { const int orow = q * 8 + (lane >> 3); *(v4u*)(Ow + (long)orow * 512 + (lane & 7) * 8) = *(const v4u*)(ost + orow * 128 + (lane & 7) * 16); } }
    __builtin_amdgcn_s_setprio(0);
    __syncthreads();
#undef SLOAD
#undef SWRITE
#undef RESC
#undef NEXT3
}
#undef SBAR
}

struct Args { const void* in[32]; float* out; unsigned char* ws; };

__device__ __forceinline__ int dst_row(int code, int n) {
    switch (code) {
    case 1: return n < 896 ? n : (n < 1152 ? 1024 + n - 896 : (n < 1184 ? 896 + n - 1152 : 1280 + n - 1184));
    case 2: { const int sel = n >> 10, j = n & 1023; return 256 * (j >> 7) + 128 * sel + (j & 127); }
    case 3: { const int h = n / 96, e = n % 96; return e < 64 ? h * 64 + e : 512 + h * 32 + e - 64; }
    case 4: { const int h = n >> 7, e = n & 127; return e < 64 ? h * 64 + e : 512 + h * 64 + e - 64; }
    default: return n;
    }
}
__device__ __forceinline__ void transpose_item(const float* W, int K, int N, bf16* WT, int code, const float* gs, LAS float* scr, int item, int lane) {
    const int nblk = N / 32, kb = item / nblk, nb = item % nblk, k0 = 64 * kb, n0 = 32 * nb;
    { f32x4 w4[8];
#pragma unroll
      for (int i = 0; i < 8; ++i) { const int kk = i * 8 + (lane >> 3); w4[i] = *(const f32x4*)(W + (size_t)(k0 + kk) * N + n0 + 4 * (lane & 7)); }
#pragma unroll
      for (int i = 0; i < 8; ++i) { const int kk = i * 8 + (lane >> 3); f32x4 w = w4[i]; if (gs) w *= gs[k0 + kk];
          LAS float* d_ = scr + kk * 33 + 4 * (lane & 7); d_[0] = w[0]; d_[1] = w[1]; d_[2] = w[2]; d_[3] = w[3]; } }
    LDS_WAIT(); asm volatile("" ::: "memory");
    const int c = lane & 7; const int r0 = dst_row(code, n0);
#pragma unroll
    for (int j = 0; j < 4; ++j) { const int n = (lane >> 3) + 8 * j; const LAS float* s = scr + (8 * c) * 33 + n;
        v4u o; o.x = pk2(s[0 * 33], s[1 * 33]); o.y = pk2(s[2 * 33], s[3 * 33]); o.z = pk2(s[4 * 33], s[5 * 33]); o.w = pk2(s[6 * 33], s[7 * 33]);
        *(GAS v4u*)(WT + (size_t)(r0 + n) * K + k0 + 8 * c) = o; }
    LDS_WAIT(); asm volatile("" ::: "memory");
}
__device__ __forceinline__ void rms_rows2_to_bf16(const float* xrow0, const float* xrow1, const float* gain, bf16* orow0, bf16* orow1, int lane) {
    const f32x4* xa = (const f32x4*)xrow0 + lane; const f32x4* xb = (const f32x4*)xrow1 + lane; const f32x4* gr = (const f32x4*)gain + lane;
    f32x4 v[4], w[4]; float s = 0.f, t = 0.f;
#pragma unroll
    for (int j = 0; j < 4; ++j) { v[j] = xa[64 * j]; w[j] = xb[64 * j]; }
#pragma unroll
    for (int j = 0; j < 4; ++j) { s += (v[j].x * v[j].x + v[j].y * v[j].y) + (v[j].z * v[j].z + v[j].w * v[j].w); t += (w[j].x * w[j].x + w[j].y * w[j].y) + (w[j].z * w[j].z + w[j].w * w[j].w); }
#pragma unroll
    for (int o = 1; o < 64; o <<= 1) { s += __shfl_xor(s, o); t += __shfl_xor(t, o); }
    const float ra = rsqrtf(s * (1.f / 1024.f) + EPS), rb = rsqrtf(t * (1.f / 1024.f) + EPS);
    unsigned long long* oa = (unsigned long long*)orow0 + lane; unsigned long long* ob = (unsigned long long*)orow1 + lane;
#pragma unroll
    for (int j = 0; j < 4; ++j) { const f32x4 gg = gr[64 * j];
        oa[64 * j] = (unsigned long long)pk2(v[j].x * ra * gg.x, v[j].y * ra * gg.y) | ((unsigned long long)pk2(v[j].z * ra * gg.z, v[j].w * ra * gg.w) << 32);
        ob[64 * j] = (unsigned long long)pk2(w[j].x * rb * gg.x, w[j].y * rb * gg.y) | ((unsigned long long)pk2(w[j].z * rb * gg.z, w[j].w * rb * gg.w) << 32); }
}
__device__ __forceinline__ void rms_row_to_f32(const float* xrow, const float* gain, float* orow, int lane) {
    const f32x4* xr = (const f32x4*)xrow + lane; const f32x4* gr = (const f32x4*)gain + lane;
    f32x4 v[4]; float s = 0.f;
#pragma unroll
    for (int j = 0; j < 4; ++j) { v[j] = xr[64 * j]; s += (v[j].x * v[j].x + v[j].y * v[j].y) + (v[j].z * v[j].z + v[j].w * v[j].w); }
    const float rstd = rsqrtf(wave_sum(s) * (1.f / 1024.f) + EPS);
    f32x4* o = (f32x4*)orow + lane;
#pragma unroll
    for (int j = 0; j < 4; ++j) { const f32x4 gg = gr[64 * j]; o[64 * j] = (f32x4){v[j].x * rstd * gg.x, v[j].y * rstd * gg.y, v[j].z * rstd * gg.z, v[j].w * rstd * gg.w}; }
}

struct SsmP { const float *lam_re, *lam_im, *log_dt, *b_re, *b_im, *c_re, *c_im, *dsk; };
__device__ __forceinline__ void ssm_pow(const SsmP& P, int dir, int g, int p, float e, float& pr, float& pi_) {
    const int ix = (dir * 32 + g) * 64 + p; const float dt = __expf(P.log_dt[dir * 32 + g]);
    const float mag = __expf(e * P.lam_re[ix] * dt); float sn, cs; sincos_rev(e * P.lam_im[ix] * dt, sn, cs); pr = mag * cs; pi_ = mag * sn;
}
__device__ __forceinline__ void ssm_fbar(const SsmP& P, int dir, int g, int p, float& fr, float& fi) {
    const int ix = (dir * 32 + g) * 64 + p; float ar, ai; ssm_pow(P, dir, g, p, 1.0f, ar, ai);
    const float lr = P.lam_re[ix], li = P.lam_im[ix], nr = ar - 1.0f, den = lr * lr + li * li;
    fr = (nr * lr + ai * li) / den; fi = (ai * lr - nr * li) / den;
}
__device__ __forceinline__ void ssm_lag_item(const SsmP& P, bf16* MF, int g, int j, LAS float* scr, int lane) {
    float acc4[4] = {0.f, 0.f, 0.f, 0.f};
    const int c = lane >> 2, cp0 = (lane & 3) * 4;
    for (int dir = 0; dir < 2; ++dir) {
        if ((dir == 0 && j < 0) || (dir == 1 && j > 0)) continue;
        const int p = lane; float pr, pi_, fr, fi; ssm_pow(P, dir, g, p, (float)(j < 0 ? -j : j), pr, pi_); ssm_fbar(P, dir, g, p, fr, fi);
        const float wr_ = pr * fr - pi_ * fi, wi_ = pr * fi + pi_ * fr;
        const float* br = P.b_re + ((size_t)((dir * 32 + g) * 64 + p)) * 16; const float* bi = P.b_im + ((size_t)((dir * 32 + g) * 64 + p)) * 16;
#pragma unroll
        for (int q = 0; q < 16; ++q) { const float zr = wr_ * br[q] - wi_ * bi[q], zi = wr_ * bi[q] + wi_ * br[q]; scr[(p * 16 + q) * 2] = zr; scr[(p * 16 + q) * 2 + 1] = zi; }
        LDS_WAIT(); asm volatile("" ::: "memory");
        const float* cr = P.c_re + ((size_t)((dir * 32 + g) * 16 + c)) * 64; const float* ci = P.c_im + ((size_t)((dir * 32 + g) * 16 + c)) * 64;
        for (int pp = 0; pp < 64; ++pp) { const float a = cr[pp], b = ci[pp];
#pragma unroll
            for (int q = 0; q < 4; ++q) acc4[q] += a * scr[(pp * 16 + cp0 + q) * 2] - b * scr[(pp * 16 + cp0 + q) * 2 + 1]; }
        LDS_WAIT(); asm volatile("" ::: "memory");
    }
    if (j == 0) {
#pragma unroll
        for (int q = 0; q < 4; ++q) if (cp0 + q == c) acc4[q] += P.dsk[g * 16 + c];
    }
    const v2u w = {pk2(acc4[0], acc4[1]), pk2(acc4[2], acc4[3])};
    const int tlo = j > 0 ? j : 0, thi = j < 0 ? 31 + j : 31;
    for (int t = tlo; t <= thi; ++t) *(v2u*)(MF + ((size_t)(g * 512 + t * 16 + c)) * UPITCH + (t - j) * 16 + cp0) = w;
}
__device__ __forceinline__ void ssm_out_item(const SsmP& P, bf16* MF, int g, int t, int lane) {
    const int p = lane;
    for (int dir = 0; dir < 2; ++dir) {
        float pr, pi_; ssm_pow(P, dir, g, p, dir == 0 ? (float)(t + 1) : (float)(TCH - t), pr, pi_);
        for (int c = 0; c < 16; ++c) { const size_t ci = ((size_t)((dir * 32 + g) * 16 + c)) * 64 + p; const float cr = P.c_re[ci], cim = P.c_im[ci];
            const float zr = cr * pr - cim * pi_, zi = cr * pi_ + cim * pr;
            *(unsigned*)(MF + ((size_t)(g * 512 + t * 16 + c)) * UPITCH + 512 + dir * 128 + p * 2) = pk2(zr, -zi); }
    }
}
__device__ __forceinline__ void ssm_st_item(const SsmP& P, bf16* WST, int g, int dir, int p, int lane) {
    const int tp = lane >> 1, c0 = (lane & 1) * 8;
    float pr, pi_, fr, fi; ssm_pow(P, dir, g, p, dir == 0 ? (float)(TCH - 1 - tp) : (float)tp, pr, pi_); ssm_fbar(P, dir, g, p, fr, fi);
    const float wr_ = pr * fr - pi_ * fi, wi_ = pr * fi + pi_ * fr;
    const float* br = P.b_re + ((size_t)((dir * 32 + g) * 64 + p)) * 16 + c0; const float* bi = P.b_im + ((size_t)((dir * 32 + g) * 64 + p)) * 16 + c0;
    float zr[8], zi[8];
#pragma unroll
    for (int q = 0; q < 8; ++q) { zr[q] = wr_ * br[q] - wi_ * bi[q]; zi[q] = wr_ * bi[q] + wi_ * br[q]; }
    bf16* row = WST + ((size_t)(g * 256 + dir * 128 + p * 2)) * 512 + tp * 16 + c0;
    *(v4u*)row = pg8::pack8(zr); *(v4u*)(row + 512) = pg8::pack8(zi);
}

#define INS16(t, x) do { float x_ = (x); _Pragma("unroll") for (int i_ = 0; i_ < 16; ++i_) { const float a_ = fmaxf(t[i_], x_); x_ = fminf(t[i_], x_); t[i_] = a_; } } while (0)
#define CE_DESC(x, y) do { const float hi_ = fmaxf(x, y), lo_ = fminf(x, y); x = hi_; y = lo_; } while (0)
__device__ __forceinline__ void sort16_desc(float (&a)[16]) {
#pragma unroll
    for (int k = 2; k <= 16; k <<= 1)
#pragma unroll
        for (int j = k >> 1; j > 0; j >>= 1)
#pragma unroll
            for (int i = 0; i < 16; ++i) { const int l = i ^ j; if (l > i) { if ((i & k) == 0) CE_DESC(a[i], a[l]); else CE_DESC(a[l], a[i]); } }
}
__device__ __forceinline__ void merge16_desc(float (&t)[16], const float (&a)[16]) {
#pragma unroll
    for (int i = 0; i < 16; ++i) t[i] = fmaxf(t[i], a[15 - i]);
#pragma unroll
    for (int j = 8; j > 0; j >>= 1)
#pragma unroll
        for (int i = 0; i < 16; ++i) { const int l = i ^ j; if (l > i) CE_DESC(t[i], t[l]); }
}
__device__ __forceinline__ float packf(float v, unsigned code, unsigned mask) { return __builtin_bit_cast(float, (__builtin_bit_cast(unsigned, v) & ~mask) | code); }
__device__ __forceinline__ unsigned fp8x4(float a, float b, float c, float d) { int t = __builtin_amdgcn_cvt_pk_fp8_f32(a, b, 0, false); t = __builtin_amdgcn_cvt_pk_fp8_f32(c, d, t, true); return (unsigned)t; }
#define DEC8(w, lo, hi) do { lo = __builtin_amdgcn_cvt_pk_f32_fp8((int)(w), false); hi = __builtin_amdgcn_cvt_pk_f32_fp8((int)(w), true); } while (0)

__device__ __forceinline__ void peer_topk(unsigned char* ws, LAS unsigned char* ldsw, int gw, int NGW, int lane_) {
    int lane = lane_; asm volatile("" : "+v"(lane));
    const _Float16* SC = (const _Float16*)(ws + WS_SC);
    unsigned* SELI = (unsigned*)(ws + WS_SELI); float* SELW = (float*)(ws + WS_SELG);
    LAS unsigned* idxb = (LAS unsigned*)ldsw;
    v4u pf[16];
    if (gw < NTOK / 4) { const v4u* gp = (const v4u*)(SC + (size_t)gw * 4 * 2048) + lane;
#pragma unroll
        for (int b = 0; b < 16; ++b) pf[b] = gp[b * 64]; }
    for (int grp = gw; grp < NTOK / 4; grp += NGW) {
        const int tok0 = grp * 4;
        const float q2_ = fx_get((const u64*)(ws + WS_SSQ2) + tok0 + (lane >> 4));
#pragma unroll
        for (int b = 0; b < 16; ++b) { const int list = b * 4 + (lane >> 4), c = lane & 15; *(LAS v4u*)(ldsw + list * 256 + ((c ^ (list & 15)) << 4)) = pf[b]; }
        LDS_WAIT(); asm volatile("" ::: "memory");
        if (grp + NGW < NTOK / 4) { const v4u* gp = (const v4u*)(SC + (size_t)(grp + NGW) * 4 * 2048) + lane;
#pragma unroll
            for (int b = 0; b < 16; ++b) pf[b] = gp[b * 64]; }
        float t[16];
#pragma unroll
        for (int g = 0; g < 8; ++g) {
            float a[16];
#pragma unroll
            for (int hf = 0; hf < 2; ++hf) { const int i = g * 2 + hf; const v4u w = *(const LAS v4u*)(ldsw + lane * 256 + ((i ^ (lane & 15)) << 4));
                const unsigned ww[4] = {w.x, w.y, w.z, w.w};
#pragma unroll
                for (int q = 0; q < 4; ++q) { const h2_t h2 = __builtin_bit_cast(h2_t, ww[q]); const unsigned k = (unsigned)(i * 8 + q * 2);
                    a[hf * 8 + q * 2] = packf((float)h2.x, k, 127u); a[hf * 8 + q * 2 + 1] = packf((float)h2.y, k + 1, 127u); } }
            sort16_desc(a);
            if (g == 0) {
#pragma unroll
                for (int i = 0; i < 16; ++i) t[i] = a[i];
            } else merge16_desc(t, a);
        }
        LDS_WAIT(); asm volatile("" ::: "memory");
        { unsigned w0 = 0, w1 = 0, w2 = 0, w3 = 0;
#pragma unroll
          for (int i = 0; i < 4; ++i) { w0 |= (__builtin_bit_cast(unsigned, t[i]) & 127u) << (8 * i); w1 |= (__builtin_bit_cast(unsigned, t[4 + i]) & 127u) << (8 * i);
                                        w2 |= (__builtin_bit_cast(unsigned, t[8 + i]) & 127u) << (8 * i); w3 |= (__builtin_bit_cast(unsigned, t[12 + i]) & 127u) << (8 * i); }
          idxb[lane * 4 + 0] = w0; idxb[lane * 4 + 1] = w1; idxb[lane * 4 + 2] = w2; idxb[lane * 4 + 3] = w3; }
        float s2[16];
#pragma unroll
        for (int i = 0; i < 16; ++i) { t[i] = packf(t[i], 0u, 127u); s2[i] = __shfl_xor(t[i], 1); }
        float cd[16], cb[16], cc_[16], cx[2];
        { int n = 0;
#pragma unroll
          for (int a = 0; a < 16; ++a)
#pragma unroll
            for (int b = 0; b < 16; ++b) if ((a + 1) * (b + 1) <= 16) { const float v_ = packf(t[a] + s2[b], (unsigned)(a * 16 + b), 255u);
                if (n < 16) cd[n] = v_; else if (n < 32) cb[n - 16] = v_; else if (n < 48) cc_[n - 32] = v_; else cx[n - 48] = v_;
                ++n; } }
        sort16_desc(cd); sort16_desc(cb); sort16_desc(cc_);
        merge16_desc(cd, cb); merge16_desc(cd, cc_);
        INS16(cd, cx[0]); INS16(cd, cx[1]);
        LDS_WAIT(); asm volatile("" ::: "memory");
        if ((lane & 1) == 0) {
            const float rs = rsqrtf(q2_ * (1.0f / 1024.0f) + EPS) * 1.4426950408889634f;
            const float m = packf(cd[0], 0u, 255u); float e[16], sum = 0.f;
#pragma unroll
            for (int i = 0; i < 16; ++i) { e[i] = __builtin_amdgcn_exp2f((packf(cd[i], 0u, 255u) - m) * rs); sum += e[i]; }
            const float inv = 1.0f / sum;
            const int tl = lane >> 4, head = (lane >> 1) & 7;
            const LAS unsigned char* ib = (const LAS unsigned char*)idxb;
            unsigned ids[16];
#pragma unroll
            for (int i = 0; i < 16; ++i) { const unsigned code = __builtin_bit_cast(unsigned, cd[i]) & 255u, a = code >> 4, b = code & 15u;
                ids[i] = (unsigned)ib[lane * 16 + a] * 128u + (unsigned)ib[(lane + 1) * 16 + b]; e[i] *= inv; }
            v4u* pi = (v4u*)((unsigned short*)SELI + (size_t)(tok0 + tl) * 128 + head * 16); f32x4* pw = (f32x4*)(SELW + (size_t)(tok0 + tl) * 128 + head * 16);
            pi[0] = (v4u){ids[0] | (ids[1] << 16), ids[2] | (ids[3] << 16), ids[4] | (ids[5] << 16), ids[6] | (ids[7] << 16)};
            pi[1] = (v4u){ids[8] | (ids[9] << 16), ids[10] | (ids[11] << 16), ids[12] | (ids[13] << 16), ids[14] | (ids[15] << 16)};
#pragma unroll
            for (int i = 0; i < 4; ++i) pw[i] = (f32x4){e[4 * i], e[4 * i + 1], e[4 * i + 2], e[4 * i + 3]};
        }
        LDS_WAIT(); asm volatile("" ::: "memory");
    }
}

#define TR16(acc, o0, o1, M2, M1, M0) do { float r8_[8], r4_[4]; \
    { const bool up_ = (lane & (M2)) != 0; _Pragma("unroll") for (int i_ = 0; i_ < 8; ++i_) { const float s_ = up_ ? acc[i_] : acc[8 + i_]; const float k_ = up_ ? acc[8 + i_] : acc[i_]; r8_[i_] = k_ + __shfl_xor(s_, (M2)); } } \
    { const bool up_ = (lane & (M1)) != 0; _Pragma("unroll") for (int i_ = 0; i_ < 4; ++i_) { const float s_ = up_ ? r8_[i_] : r8_[4 + i_]; const float k_ = up_ ? r8_[4 + i_] : r8_[i_]; r4_[i_] = k_ + __shfl_xor(s_, (M1)); } } \
    { const bool up_ = (lane & (M0)) != 0; const float s0_ = up_ ? r4_[0] : r4_[2], k0_ = up_ ? r4_[2] : r4_[0], s1_ = up_ ? r4_[1] : r4_[3], k1_ = up_ ? r4_[3] : r4_[1]; \
      o0 = k0_ + __shfl_xor(s0_, (M0)); o1 = k1_ + __shfl_xor(s1_, (M0)); } } while (0)

#define XSUM32(a, b) ({ const auto r_ = __builtin_amdgcn_permlane32_swap((unsigned)(a), (unsigned)(b), false, false); (int)(r_[0] + r_[1]); })
#define XSUM16(a, b) ({ const auto r_ = __builtin_amdgcn_permlane16_swap((unsigned)(a), (unsigned)(b), false, false); (int)(r_[0] + r_[1]); })
#define ROR8(v) __builtin_amdgcn_update_dpp(0, (int)(v), 0x128, 0xf, 0xf, false)

#define STAGE() __builtin_amdgcn_sched_barrier(0)
#define VINIT(x, y) asm volatile("v_mov_b32 %0, %1" : "=v"(x) : "v"(y))
__device__ __forceinline__ void u4_token(const v4u (&R)[16], const v4u (&xc)[2], int lane, float* dst) {
#define SD4(a, b, c) __builtin_amdgcn_sdot4((int)(a), (int)(b), (c), false)
    const unsigned X[8] = {xc[0].x, xc[0].y, xc[0].z, xc[0].w, xc[1].x, xc[1].y, xc[1].z, xc[1].w};
    int sl_ = SD4(X[0], 0x01010101, 0), sl2_ = SD4(X[2], 0x01010101, 0), sh_ = SD4(X[1], 0x01010101, 0), sh2_ = SD4(X[3], 0x01010101, 0);
    STAGE();
    sl_ = SD4(X[4], 0x01010101, sl_); sl2_ = SD4(X[6], 0x01010101, sl2_); sh_ = SD4(X[5], 0x01010101, sh_); sh2_ = SD4(X[7], 0x01010101, sh2_);
    STAGE();
    const int c0 = 8 * (sh_ + sh2_) - 120 * (sl_ + sl2_), zero_ = 0;
    int acc[16];
#pragma unroll
    for (int g = 0; g < 4; ++g) {
        unsigned aL[4][4], aH[4][4]; int lo[4], hi[4];
#pragma unroll
        for (int r = 0; r < 4; ++r) { const v4u w_ = R[4 * g + r]; const unsigned ww[4] = {w_.x, w_.y, w_.z, w_.w};
#pragma unroll
            for (int d = 0; d < 4; ++d) { aL[r][d] = ww[d] & 0x0F0F0F0Fu; aH[r][d] = ww[d] & 0xF0F0F0F0u; }
            VINIT(lo[r], zero_); VINIT(hi[r], c0); }
        STAGE();
#pragma unroll
        for (int r = 0; r < 4; ++r) { lo[r] = SD4(aL[r][0], X[0], lo[r]); hi[r] = SD4(aH[r][0], X[1], hi[r]); }
        STAGE();
#pragma unroll
        for (int r = 0; r < 4; ++r) { lo[r] = SD4(aL[r][1], X[2], lo[r]); hi[r] = SD4(aH[r][1], X[3], hi[r]); }
        STAGE();
#pragma unroll
        for (int r = 0; r < 4; ++r) { lo[r] = SD4(aL[r][2], X[4], lo[r]); hi[r] = SD4(aH[r][2], X[5], hi[r]); }
        STAGE();
#pragma unroll
        for (int r = 0; r < 4; ++r) { lo[r] = SD4(aL[r][3], X[6], lo[r]); hi[r] = SD4(aH[r][3], X[7], hi[r]); }
        STAGE();
#pragma unroll
        for (int r = 0; r < 4; ++r) acc[4 * g + r] = (lo[r] << 4) + hi[r];
    }
#undef SD4
    STAGE();
    int k8[8], s8[8], r8[8], k4[4], s4[4], r4[4], o0, o1;
    { const bool up_ = (lane & 1) != 0;
#pragma unroll
      for (int i = 0; i < 8; ++i) { k8[i] = up_ ? acc[8 + i] : acc[i]; s8[i] = up_ ? acc[i] : acc[8 + i]; } }
    STAGE();
#pragma unroll
    for (int i = 0; i < 8; ++i) r8[i] = k8[i] + __builtin_amdgcn_update_dpp(0, s8[i], 0xB1, 0xf, 0xf, false);
    STAGE();
    { const bool up_ = (lane & 2) != 0;
#pragma unroll
      for (int i = 0; i < 4; ++i) { k4[i] = up_ ? r8[4 + i] : r8[i]; s4[i] = up_ ? r8[i] : r8[4 + i]; } }
    STAGE();
#pragma unroll
    for (int i = 0; i < 4; ++i) r4[i] = k4[i] + __builtin_amdgcn_update_dpp(0, s4[i], 0x4E, 0xf, 0xf, false);
    STAGE();
    { const bool up_ = (lane & 4) != 0; const int s0_ = up_ ? r4[0] : r4[2], s1_ = up_ ? r4[1] : r4[3], k0_ = up_ ? r4[2] : r4[0], k1_ = up_ ? r4[3] : r4[1];
      int x0_ = __builtin_amdgcn_update_dpp(0, s0_, 0x104, 0xf, 0x5, false); int x1_ = __builtin_amdgcn_update_dpp(0, s1_, 0x104, 0xf, 0x5, false);
      x0_ = __builtin_amdgcn_update_dpp(x0_, s0_, 0x114, 0xf, 0xA, false); x1_ = __builtin_amdgcn_update_dpp(x1_, s1_, 0x114, 0xf, 0xA, false);
      o0 = k0_ + x0_; o1 = k1_ + x1_; }
    const int cc = (lane & 1) * 8 + ((lane >> 1) & 1) * 4 + ((lane >> 2) & 1) * 2;
    *(f32x2*)(dst + cc) = (f32x2){(float)o0, (float)o1};
}
#define PEER_LD_IDS(dst, t) do { dst[0] = *(const v4u*)(SELI + (size_t)(t) * 128 + rg * 16); dst[1] = *(const v4u*)(SELI + (size_t)(t) * 128 + rg * 16 + 8); } while (0)
#define PEER_LD_ROWS16(dst, ids) do { _Pragma("unroll") for (int h_ = 0; h_ < 2; ++h_) { const v4u q_ = ids[h_]; \
        const unsigned e_[8] = {q_.x & 0xffffu, q_.x >> 16, q_.y & 0xffffu, q_.y >> 16, q_.z & 0xffffu, q_.z >> 16, q_.w & 0xffffu, q_.w >> 16}; \
        _Pragma("unroll") for (int i_ = 0; i_ < 8; ++i_) dst[h_ * 8 + i_] = *(const v4u*)(TAB + (size_t)e_[i_] * 128 + ch * 16); } } while (0)
__device__ __forceinline__ void peer_u4_pass(unsigned char* ws, int part, int wv, int nwv, int lane_) {
    int lane = lane_; asm volatile("" : "+v"(lane));
    const unsigned short* SELI = (const unsigned short*)(ws + WS_SELI);
    const unsigned char* H8 = ws + WS_H8 + part * 256;
    const unsigned char* TAB = ws + WS_PU4 + (size_t)part * 16384 * 128;
    float* PART = (float*)(ws + WS_PART) + (size_t)part * NTOK * 128;
    const int rg = lane >> 3, ch = lane & 7;
    if (wv >= NTOK) return;
#define LD_X(dst, t) do { const v4u* p_ = (const v4u*)(H8 + (size_t)(t) * 1024 + ch * 32); dst[0] = p_[0]; dst[1] = p_[1]; } while (0)
#define STEP(RC, RN, IDC, IDN, XC, XN, tk_) do { \
        { const int t1_ = ((tk_) + nwv < NTOK) ? (tk_) + nwv : (tk_), t2_ = ((tk_) + 2 * nwv < NTOK) ? (tk_) + 2 * nwv : (tk_); \
          PEER_LD_ROWS16(RN, IDN); PEER_LD_IDS(IDC, t2_); LD_X(XN, t1_); }                \
        asm volatile("" ::: "memory"); __builtin_amdgcn_sched_barrier(0); \
        u4_token(RC, XC, lane, PART + (size_t)(tk_) * 128 + rg * 16); \
        __builtin_amdgcn_sched_barrier(0); \
        asm volatile("" : "+v"(XN[0]), "+v"(XN[1]), "+v"(IDC[0]), "+v"(IDC[1])); } while (0)
    v4u idA[2], idB[2], xA[2], xB[2], RA[16], RB[16];
    PEER_LD_IDS(idA, wv); LD_X(xA, wv);
    { const int t1 = (wv + nwv < NTOK) ? wv + nwv : wv; PEER_LD_IDS(idB, t1); }
    PEER_LD_ROWS16(RA, idA);
    for (int tk = wv; tk < NTOK; tk += 2 * nwv) {
        STEP(RA, RB, idA, idB, xA, xB, tk);
        if (tk + nwv < NTOK) STEP(RB, RA, idB, idA, xB, xA, tk + nwv);
    }
#undef LD_X
#undef STEP
}

__device__ __forceinline__ void v4_grp(const v4u& R0, const v4u& R1, const v4u& R2, const v4u& R3, unsigned Wq, int (&alo)[16], int (&ahi)[16]) {
    const unsigned r0[4] = {R0.x, R0.y, R0.z, R0.w}, r1[4] = {R1.x, R1.y, R1.z, R1.w}, r2[4] = {R2.x, R2.y, R2.z, R2.w}, r3[4] = {R3.x, R3.y, R3.z, R3.w};
    unsigned A[4], B[4], C[4], D[4], T[16], L[16];
#pragma unroll
    for (int d = 0; d < 4; ++d) { A[d] = __builtin_amdgcn_perm(r1[d], r0[d], 0x05010400u); B[d] = __builtin_amdgcn_perm(r1[d], r0[d], 0x07030602u);
                                  C[d] = __builtin_amdgcn_perm(r3[d], r2[d], 0x05010400u); D[d] = __builtin_amdgcn_perm(r3[d], r2[d], 0x07030602u); }
    STAGE();
#pragma unroll
    for (int d = 0; d < 4; ++d) { T[d * 4 + 0] = __builtin_amdgcn_perm(C[d], A[d], 0x05040100u); T[d * 4 + 1] = __builtin_amdgcn_perm(C[d], A[d], 0x07060302u);
                                  T[d * 4 + 2] = __builtin_amdgcn_perm(D[d], B[d], 0x05040100u); T[d * 4 + 3] = __builtin_amdgcn_perm(D[d], B[d], 0x07060302u); }
    STAGE();
#pragma unroll
    for (int i = 0; i < 16; ++i) L[i] = T[i] & 0x0F0F0F0Fu;
    STAGE();
#pragma unroll
    for (int i = 0; i < 16; ++i) { alo[i] = __builtin_amdgcn_sdot4((int)L[i], (int)Wq, alo[i], false);
                                   ahi[i] = __builtin_amdgcn_sdot4((int)T[i], (int)Wq, ahi[i], false); }
    STAGE();
}
__device__ __forceinline__ void v4_token(const v4u (&R)[16], const v4u& wc, float osc, int lane, _Float16* dst) {
    int alo[16], ahi[16];
#pragma unroll
    for (int i = 0; i < 16; ++i) { VINIT(alo[i], 0); VINIT(ahi[i], 0); }
    STAGE();
    v4_grp(R[0], R[1], R[2], R[3], wc.x, alo, ahi); v4_grp(R[4], R[5], R[6], R[7], wc.y, alo, ahi);
    v4_grp(R[8], R[9], R[10], R[11], wc.z, alo, ahi); v4_grp(R[12], R[13], R[14], R[15], wc.w, alo, ahi);
    int sw_ = __builtin_amdgcn_sdot4((int)wc.x, 0x01010101, 0, false); sw_ = __builtin_amdgcn_sdot4((int)wc.y, 0x01010101, sw_, false);
    sw_ = __builtin_amdgcn_sdot4((int)wc.z, 0x01010101, sw_, false); sw_ = __builtin_amdgcn_sdot4((int)wc.w, 0x01010101, sw_, false);
    int cv[32];
#pragma unroll
    for (int d = 0; d < 4; ++d)
#pragma unroll
        for (int j = 0; j < 4; ++j) { cv[8 * d + j] = (alo[d * 4 + j] << 4) - 120 * sw_; cv[8 * d + 4 + j] = (ahi[d * 4 + j] - alo[d * 4 + j]) + 8 * sw_; }
    STAGE();
    unsigned xa[16], xb[16]; int r16[16], r8[8], k4[4], s4[4]; f32x4 o;
#pragma unroll
    for (int i = 0; i < 16; ++i) { const auto r_ = __builtin_amdgcn_permlane32_swap((unsigned)cv[i], (unsigned)cv[16 + i], false, false); xa[i] = r_[0]; xb[i] = r_[1]; }
    STAGE();
#pragma unroll
    for (int i = 0; i < 16; ++i) r16[i] = (int)(xa[i] + xb[i]);
    STAGE();
#pragma unroll
    for (int i = 0; i < 8; ++i) { const auto r_ = __builtin_amdgcn_permlane16_swap((unsigned)r16[i], (unsigned)r16[8 + i], false, false); xa[i] = r_[0]; xb[i] = r_[1]; }
    STAGE();
#pragma unroll
    for (int i = 0; i < 8; ++i) r8[i] = (int)(xa[i] + xb[i]);
    STAGE();
    { const bool up_ = (lane & 8) != 0;
#pragma unroll
      for (int i = 0; i < 4; ++i) { k4[i] = up_ ? r8[4 + i] : r8[i]; s4[i] = up_ ? r8[i] : r8[4 + i]; } }
    STAGE();
#pragma unroll
    for (int i = 0; i < 4; ++i) o[i] = (float)(k4[i] + ROR8(s4[i])) * osc;
    const int cc = ((lane >> 5) & 1) * 16 + ((lane >> 4) & 1) * 8 + ((lane >> 3) & 1) * 4;
    *(v2u*)(dst + cc) = (v2u){pkh2(o[0], o[1]), pkh2(o[2], o[3])};
}
__device__ __forceinline__ void peer_v4_pass(unsigned char* ws, int part, int wv, int nwv, int lane_) {
    int lane = lane_; asm volatile("" : "+v"(lane));
    const unsigned short* SELI = (const unsigned short*)(ws + WS_SELI);
    const unsigned char* W8 = ws + WS_SELW; const float* WSC = (const float*)(ws + WS_WSC);
    const unsigned char* TAB = ws + WS_PV4 + (size_t)part * 16384 * 128;
    _Float16* POUT = (_Float16*)(ws + WS_POUT) + part * 256;
    const float vstep = U4_STEP * sqrtf(fx_get((const u64*)(ws + WS_TSC) + 1) * (1.0f / (1024.0f * 1024.0f))) * (1.0f / 16.0f);
    const int rg = lane >> 3, ch = lane & 7;
    if (wv >= NTOK) return;
#define LD_W(dst, sc, t) do { dst = *(const v4u*)(W8 + (size_t)(t) * 128 + rg * 16); sc = WSC[t]; } while (0)
#define STEP(RC, RN, IDC, IDN, WC, SC_, WN, SN, tk_) do { \
        { const int t1_ = ((tk_) + nwv < NTOK) ? (tk_) + nwv : (tk_), t2_ = ((tk_) + 2 * nwv < NTOK) ? (tk_) + 2 * nwv : (tk_); \
          PEER_LD_ROWS16(RN, IDN); PEER_LD_IDS(IDC, t2_); LD_W(WN, SN, t1_); }            \
        asm volatile("" ::: "memory"); __builtin_amdgcn_sched_barrier(0); \
        v4_token(RC, WC, SC_ * vstep, lane, POUT + (size_t)(tk_) * 1024 + ch * 32); \
        __builtin_amdgcn_sched_barrier(0); \
        asm volatile("" : "+v"(WN), "+v"(SN), "+v"(IDC[0]), "+v"(IDC[1])); } while (0)
    v4u idA[2], idB[2], wA, wB, RA[16], RB[16]; float sA, sB;
    PEER_LD_IDS(idA, wv); LD_W(wA, sA, wv);
    { const int t1 = (wv + nwv < NTOK) ? wv + nwv : wv; PEER_LD_IDS(idB, t1); }
    PEER_LD_ROWS16(RA, idA);
    for (int tk = wv; tk < NTOK; tk += 2 * nwv) {
        STEP(RA, RB, idA, idB, wA, sA, wB, sB, tk);
        if (tk + nwv < NTOK) STEP(RB, RA, idB, idA, wB, sB, wA, sA, tk + nwv);
    }
#undef LD_W
#undef STEP
}

__device__ __forceinline__ void peer_combine(unsigned char* ws, int gtid, int nthreads) {
    const f32x4* PART = (const f32x4*)(ws + WS_PART); const f32x4* SELG = (const f32x4*)(ws + WS_SELG); unsigned* SELW = (unsigned*)(ws + WS_SELW); float* WSC = (float*)(ws + WS_WSC);
    const u64* ssq2 = (const u64*)(ws + WS_SSQ2); const u64* ssq1 = (const u64*)(ws + WS_SSQ1);
    const float ustep = U4_STEP * sqrtf(fx_get((const u64*)(ws + WS_TSC)) * (1.0f / (1024.0f * 1024.0f))) * (1.0f / 16.0f);
    for (int i = gtid; i < NTOK * 32; i += nthreads) {
        f32x4 s = PART[i];
#pragma unroll
        for (int p = 1; p < 4; ++p) s += PART[(size_t)p * NTOK * 32 + i];
        const float sc = rsqrtf(fx_get(ssq2 + (i >> 5)) * (1.0f / 1024.0f) + EPS) * (sqrtf(fx_get(ssq1 + (i >> 5)) * (1.0f / 1024.0f) + EPS) * (1.0f / H8_SCALE)) * ustep;
        const f32x4 g = SELG[i];
        const float w0 = g[0] * gelu_tanh(s[0] * sc), w1 = g[1] * gelu_tanh(s[1] * sc), w2 = g[2] * gelu_tanh(s[2] * sc), w3 = g[3] * gelu_tanh(s[3] * sc);
        float mx = fmaxf(fmaxf(fabsf(w0), fabsf(w1)), fmaxf(fabsf(w2), fabsf(w3)));
#pragma unroll
        for (int o = 1; o < 32; o <<= 1) mx = fmaxf(mx, __shfl_xor(mx, o));
        mx = fmaxf(mx, 1.0e-30f); const float q = 127.0f / mx; unsigned pw = 0u;
        pw = __builtin_amdgcn_cvt_pk_u8_f32(__builtin_rintf(w0 * q) + 128.0f, 0, pw); pw = __builtin_amdgcn_cvt_pk_u8_f32(__builtin_rintf(w1 * q) + 128.0f, 1, pw);
        pw = __builtin_amdgcn_cvt_pk_u8_f32(__builtin_rintf(w2 * q) + 128.0f, 2, pw); pw = __builtin_amdgcn_cvt_pk_u8_f32(__builtin_rintf(w3 * q) + 128.0f, 3, pw);
        SELW[i] = pw ^ 0x80808080u; if ((i & 31) == 0) WSC[i >> 5] = mx * (1.0f / 127.0f);
    }
}

__device__ __forceinline__ void final_norm_row(const bf16* hrow, const _Float16* prow, const float* gain, float* orow, int lane) {
    const v2u* xr = (const v2u*)hrow + lane; const u64* pr = (const u64*)prow + lane;     const f32x4* gr = (const f32x4*)gain + lane;
    f32x4 v[4]; float s = 0.f;
#pragma unroll
    for (int j = 0; j < 4; ++j) { const v2u hw = xr[64 * j]; const u64 pw = pr[64 * j]; const h2_t pa = __builtin_bit_cast(h2_t, (unsigned)pw), pb = __builtin_bit_cast(h2_t, (unsigned)(pw >> 32)); v[j] = (f32x4){bf_lo(hw.x) + (float)pa.x, bf_hi(hw.x) + (float)pa.y, bf_lo(hw.y) + (float)pb.x, bf_hi(hw.y) + (float)pb.y}; s += (v[j].x * v[j].x + v[j].y * v[j].y) + (v[j].z * v[j].z + v[j].w * v[j].w); }
    const float rstd = rsqrtf(wave_sum(s) * (1.f / 1024.f) + EPS);
    f32x4* o = (f32x4*)orow + lane;
#pragma unroll
    for (int j = 0; j < 4; ++j) { const f32x4 gg = gr[64 * j]; o[64 * j] = (f32x4){v[j].x * rstd * gg.x, v[j].y * rstd * gg.y, v[j].z * rstd * gg.z, v[j].w * rstd * gg.w}; }
}

__global__ void __launch_bounds__(NWAVES * 64, 2) fwd_megakernel(Args args) {
    extern __shared__ __attribute__((aligned(16))) unsigned char lds[];
    LAS unsigned char* L = (LAS unsigned char*)lds;
    volatile LAS unsigned* MISC = (volatile LAS unsigned*)(L + MISC_OFF);
    const int wave = __builtin_amdgcn_readfirstlane((int)threadIdx.x >> 6);
#define FRESH_LANE() ({ int l_ = (int)__builtin_amdgcn_mbcnt_hi(~0u, __builtin_amdgcn_mbcnt_lo(~0u, 0u)); asm volatile("" : "+v"(l_)); l_; })
    const int G = gridDim.x, bx = blockIdx.x;
    const int vcu = (G % 8 == 0) ? (bx % 8) * (G / 8) + bx / 8 : bx;
    unsigned char* ws = args.ws;
    gu32* ctl = (gu32*)(ws + WS_CTL);
    for (int u = (int)threadIdx.x; u < (LDS_BYTES - LDSCTL_OFF) / 4; u += NWAVES * 64) ((LAS unsigned*)(L + LDSCTL_OFF))[u] = 0u;
    __syncthreads();
    XcdBarrier bar = xcd_barrier_post((unsigned*)(ctl + CW_BAR), MISC + 8);
    const int gw = vcu * NWAVES + wave, NGW = G * NWAVES;

    const float* x = (const float*)args.in[0];
    EpiArgs E;
    E.ws = ws; E.b_gate = (const float*)args.in[5]; E.x = x; E.lam_re = (const float*)args.in[6]; E.lam_im = (const float*)args.in[7]; E.log_dt = (const float*)args.in[8];

    for (int rep_ = 0; rep_ < ((REP & 8) ? 2 : 1); ++rep_) {
        const int lane = FRESH_LANE(), tid = wave * 64 + lane;
        LAS float* scr = (LAS float*)(L + wave * 16384);
        constexpr int I_IN = 16 * 101, I_GLU = 8 * 64, I_UQ = 6 * 24, I_UKV = 4 * 32, I_MO = 8 * 32, I_OUT = 16 * 32, I_MKV = 16 * 64, I_MO2 = 16 * 32;
        constexpr int NITEMS = I_IN + I_GLU + I_UQ + I_UKV + I_MO + I_OUT + I_MKV + I_MO2;
        for (int pr_ = 0; pr_ < (PRO_REP == 1 ? 2 : 1); ++pr_)
        for (int it = gw; it < NITEMS; it += NGW) {
            int r = it;
            if (r < I_IN) { transpose_item((const float*)args.in[4], 1024, 3232, (bf16*)(ws + W_IN), 1, nullptr, scr, r, lane); continue; } r -= I_IN;
            if (r < I_GLU) { transpose_item((const float*)args.in[14], 512, 2048, (bf16*)(ws + W_GLU), 2, nullptr, scr, r, lane); continue; } r -= I_GLU;
            if (r < I_UQ) { transpose_item((const float*)args.in[16], 384, 768, (bf16*)(ws + W_UQ), 3, (const float*)args.in[15], scr, r, lane); continue; } r -= I_UQ;
            if (r < I_UKV) { transpose_item((const float*)args.in[18], 256, 1024, (bf16*)(ws + W_UKV), 4, (const float*)args.in[17], scr, r, lane); continue; } r -= I_UKV;
            if (r < I_MO) { transpose_item((const float*)args.in[19], 512, 1024, (bf16*)(ws + W_MO), 0, nullptr, scr, r, lane); continue; } r -= I_MO;
            if (r < I_OUT) { transpose_item((const float*)args.in[20], 1024, 1024, (bf16*)(ws + W_OUT), 0, nullptr, scr, r, lane); continue; } r -= I_OUT;
            if (r < I_MKV) { transpose_item((const float*)args.in[24], 1024, 2048, (bf16*)(ws + W_MKV), 0, nullptr, scr, r, lane); continue; } r -= I_MKV;
            transpose_item((const float*)args.in[25], 1024, 1024, (bf16*)(ws + W_MO2), 0, nullptr, scr, r, lane);
        }
        { v4u* z = (v4u*)(ws + W_IN + (size_t)928 * 1024 * 2); const int n16 = 96 * 1024 * 2 / 16;
          for (int i = bx * 512 + tid; i < n16; i += G * 512) z[i] = (v4u){0u, 0u, 0u, 0u}; }
        for (int pr_ = 0; pr_ < (PRO_REP == 2 ? 2 : 1); ++pr_)
        { const int n8a = 1024 * 1024 / 8, n8b = 1024 * 2048 / 8;
          for (int i = bx * 512 + tid; i < n8a + n8b; i += G * 512) {
              const bool qa = i < n8a; const int j = qa ? i : i - n8a; const int k = qa ? (j >> 7) : (j >> 8);
              const float* src = (qa ? (const float*)args.in[23] : (const float*)args.in[27]) + (size_t)j * 8; const float gk = ((const float*)args.in[qa ? 21 : 26])[k];
              const f32x4 a = *(const f32x4*)src * gk, b = *(const f32x4*)(src + 4) * gk;
              *(v4u*)((bf16*)(ws + (qa ? W_MQN : W_PQN)) + (size_t)j * 8) = (v4u){pk2(a[0], a[1]), pk2(a[2], a[3]), pk2(b[0], b[1]), pk2(b[2], b[3])}; } }
        { const float* sk = (const float*)args.in[28]; bf16* SK = (bf16*)(ws + W_SK);
          for (int i = bx * 512 + tid; i < 8 * 256 * 256 / 2; i += G * 512) { const int e = i * 2, h = e >> 16, n = (e >> 8) & 255, k = e & 255, s = n >> 7;
            unsigned w = 0u; if ((k >> 7) == s) { const float* p = sk + ((size_t)((h * 2 + s) * 128 + (n & 127))) * 128 + (k & 127); w = pk2(p[0], p[1]); }
            *(unsigned*)(SK + e) = w; } }
        for (int pr_ = 0; pr_ < (PRO_REP == 3 ? 2 : 1); ++pr_)
        for (int m = 2 * gw; m < NTOK; m += 2 * NGW) rms_rows2_to_bf16(x + (size_t)m * 1024, x + (size_t)(m + 1) * 1024, (const float*)args.in[3], (bf16*)(ws + WS_XN) + (size_t)m * 1024, (bf16*)(ws + WS_XN) + (size_t)(m + 1) * 1024, lane);
        for (int m = 2 * gw; m < NMEM; m += 2 * NGW) rms_rows2_to_bf16((const float*)args.in[1] + (size_t)m * 1024, (const float*)args.in[1] + (size_t)(m + 1) * 1024, (const float*)args.in[22], (bf16*)(ws + WS_MEMN) + (size_t)m * 1024, (bf16*)(ws + WS_MEMN) + (size_t)(m + 1) * 1024, lane);
        for (int it = gw; it < 2048; it += NGW) { const bool isu = it < 1024; const float* row = (const float*)args.in[isu ? 29 : 30] + (size_t)((it & 1023) * 16) * 1024; float sq = 0.f;
#pragma unroll
            for (int k = 0; k < 4; ++k) { f32x4 a = *(const f32x4*)(row + k * 256 + lane * 4); if (isu) a *= *(const f32x4*)((const float*)args.in[26] + k * 256 + lane * 4); sq += (a[0] * a[0] + a[1] * a[1]) + (a[2] * a[2] + a[3] * a[3]); }
            sq = wave_sum(sq); if (lane == 0) fx_add((u64*)(ws + WS_TSC) + (isu ? 0 : 1), sq); }
        for (int pr_ = 0; pr_ < (PRO_REP == 4 ? 2 : 1); ++pr_)
        { const int* pos = (const int*)args.in[2]; f32x2* tab = (f32x2*)(ws + WS_TAB);
          for (int i = bx * 512 + tid; i < NTOK * 16; i += G * 512) { const int tk = i >> 4, f = i & 15;
            const float inv = 1.0f / exp2f((float)f * 0.830482023721841f); const float ang = (float)pos[tk] * inv; float sn, cs; sincos_rev(ang, sn, cs); tab[i] = (f32x2){cs, sn}; } }
        { SsmP P{(const float*)args.in[6], (const float*)args.in[7], (const float*)args.in[8], (const float*)args.in[9], (const float*)args.in[10], (const float*)args.in[11], (const float*)args.in[12], (const float*)args.in[13]};
          bf16* MF = (bf16*)(ws + WS_MFULL); bf16* WST = (bf16*)(ws + WS_WST);
          constexpr int NL = 32 * 63, NO = 32 * 32, NS = 32 * 2 * 64;
          for (int pr_ = 0; pr_ < (PRO_REP == 5 ? 2 : 1); ++pr_)
          for (int it = (gw + NGW / 2) % NGW; it < NL + NO + NS; it += NGW) {
              if (it < NL) ssm_lag_item(P, MF, it / 63, it % 63 - 31, scr, lane);
              else if (it < NL + NO) { const int r = it - NL; ssm_out_item(P, MF, r >> 5, r & 31, lane); }
              else { const int r = it - NL - NO; ssm_st_item(P, WST, r >> 7, (r >> 6) & 1, r & 63, lane); }
          } }
    }
    xcd_barrier(bar);

    pg8::GemmDesc g; int gi_ = 0;
#define GEMMC(cc, ...) do { g = pg8::GemmDesc{__VA_ARGS__}; const bool rp_ = (REPG < 0 || REPG == gi_); ++gi_; if (rp_ && (REP & 1)) pg8::gemm_phase<true>(L, g, E, G, (cc), 1); if (rp_ && (REP & 128)) pg8::gemm_phase<true>(L, g, E, G, (cc), 2); pg8::gemm_phase<true>(L, g, E, G, (cc)); } while (0)
#define GEMM(...) GEMMC(bx, __VA_ARGS__)
#if DEBUG_STAGE >= 1
    GEMM((const bf16*)(ws + WS_XN), nullptr, (const bf16*)(ws + W_IN), nullptr, 1024, 1024, 1024, 128, 13, 1, pg8::ORD_STD, pg8::EK_IN, 0, 0, 0, 0);
    GEMMC((bx + G / 2) % G, (const bf16*)(ws + WS_MEMN), nullptr, (const bf16*)(ws + W_MKV), nullptr, 1024, 1024, 1024, 8, 8, 1, pg8::ORD_STD, pg8::EK_MEMKV, 0, 0, 0, 0);
    GEMMC((bx + G / 4) % G, (const bf16*)(ws + W_SK), nullptr, (const bf16*)(ws + W_PQN), nullptr, 256, 2048, 256, 1, 4, 8, pg8::ORD_Z, pg8::EK_W1, 0, 65536, 256, 0);
    xcd_barrier(bar);
    GEMM((const bf16*)(ws + WS_U), nullptr, (const bf16*)(ws + WS_WST), nullptr, UPITCH, 512, 512, 4, 1, 32, pg8::ORD_Z, pg8::EK_SLOC, 1, (long)NCHUNK * UPITCH, (long)256 * 512, 0);
    GEMMC((bx + G / 2) % G, (const bf16*)(ws + WS_CQ), nullptr, (const bf16*)(ws + W_UQ), nullptr, 384, 384, 384, 128, 3, 1, pg8::ORD_STD, pg8::EK_Q, 0, 0, 0, 0);
    GEMM((const bf16*)(ws + WS_CKV), nullptr, (const bf16*)(ws + W_UKV), nullptr, 256, 256, 256, 128, 4, 1, pg8::ORD_STD, pg8::EK_KV, 0, 0, 0, 0);
    xcd_barrier(bar);
    {
        const int xg = vcu >> 5, jj = vcu & 31;
        for (int i_ = 0; i_ < ((REP & 2) ? 8 : 4); ++i_) { const int i = i_ & 3;
            const int ui = i * 32 + jj, pair = xg * 8 + (ui >> 4), qb = ui & 15;
            if (pair < 64) {
                const int b = pair >> 3, h = pair & 7;
                const bf16* Qp = (const bf16*)(ws + WS_Q) + ((size_t)(pair * SEQ + qb * 256)) * 96;
                const bf16* Kp = (const bf16*)(ws + WS_K) + (size_t)pair * SEQ * 96;
                const bf16* Vp = (const bf16*)(ws + WS_V) + (size_t)pair * SEQ * 64;
                bf16* Op = (bf16*)(ws + WS_ATT) + ((size_t)(b * SEQ + qb * 256)) * 512 + h * 64;
                att::attn_unit(Qp, Kp, Vp, Op, (char*)lds);
            }
        }
    }
    GEMM((const bf16*)(ws + WS_U), nullptr, (const bf16*)(ws + WS_MFULL), nullptr, UPITCH, UPITCH, 768, 4, 2, 32, pg8::ORD_Z, pg8::EK_Y, 0, (long)NCHUNK * UPITCH, (long)512 * UPITCH, 0);
    GEMM((const bf16*)(ws + WS_KM), nullptr, (const bf16*)(ws + W_MQN), nullptr, 256, 1024, 256, 8, 4, 4, pg8::ORD_Z, pg8::EK_W2, 0, (long)8 * 65536, 256, 0);
    GEMMC((bx + G / 2) % G, (const bf16*)(ws + W_MO2), nullptr, (const bf16*)(ws + WS_VT), nullptr, 1024, 256, 256, 4, 8, 4, pg8::ORD_Z, pg8::EK_W3, 0, 256, (long)8 * 65536, 0);
    xcd_barrier(bar);
    GEMM((const bf16*)(ws + WS_YS), (const bf16*)(ws + WS_ATT), (const bf16*)(ws + W_GLU), (const bf16*)(ws + W_MO), 512, 512, 512, 128, 4, 1, pg8::ORD_DUAL, pg8::EK_P4, 0, 0, 0, 0);
    xcd_barrier(bar);
    GEMM((const bf16*)(ws + WS_MERGED), nullptr, (const bf16*)(ws + W_OUT), nullptr, 1024, 1024, 1024, 128, 4, 1, pg8::ORD_STD, pg8::EK_OUT, 0, 0, 0, 0);
    xcd_barrier(bar);
#endif
#if DEBUG_STAGE >= 2
    GEMM((const bf16*)(ws + WS_HB), nullptr, (const bf16*)(ws + WS_W2), nullptr, 1024, 1024, 1024, 128, 4, 1, pg8::ORD_STD, pg8::EK_MS2, 0, 0, 0, (long)1024 * 1024);
    xcd_barrier(bar);
    GEMM((const bf16*)(ws + WS_PM), nullptr, (const bf16*)(ws + WS_W3), nullptr, 1024, 1024, 1024, 128, 4, 1, pg8::ORD_STD, pg8::EK_MO, 0, 0, 0, (long)1024 * 1024);
#if DEBUG_STAGE >= 9
    {
        const int lane = FRESH_LANE(); const bool odd = (lane & 1) != 0;
        const f32x4* pu = (const f32x4*)args.in[29]; const f32x4* pv = (const f32x4*)args.in[30];
        const float uinv = 1.0f / (U4_STEP * sqrtf(fx_get((const u64*)(ws + WS_TSC)) * (1.0f / (1024.0f * 1024.0f)))), vinv = 1.0f / (U4_STEP * sqrtf(fx_get((const u64*)(ws + WS_TSC) + 1) * (1.0f / (1024.0f * 1024.0f))));
        f32x4 gq[4];
#pragma unroll
        for (int q = 0; q < 4; ++q) gq[q] = *(const f32x4*)((const float*)args.in[26] + q * 256 + 4 * lane) * uinv;
        const int nadd = odd ? 16 : 8, nsh = odd ? 4 : 0;
        for (int it = gw; it < 16384 / 2; it += NGW) {
            const size_t b4 = (size_t)it * 512; f32x4 ru[8], rv[8];
#pragma unroll
            for (int k = 0; k < 8; ++k) { ru[k] = pu[b4 + k * 64 + lane]; rv[k] = pv[b4 + k * 64 + lane]; }
#pragma unroll
            for (int k = 0; k < 8; ++k) { const f32x4 a = ru[k] * gq[k & 3], b = rv[k] * vinv; unsigned wu = 0u, wv = 0u;
#pragma unroll
                for (int j = 0; j < 4; ++j) { const int na = (int)__builtin_amdgcn_fmed3f(__builtin_floorf(a[j]), -8.0f, 7.0f), nb = (int)__builtin_amdgcn_fmed3f(__builtin_floorf(b[j]), -8.0f, 7.0f);
                    wu |= ((unsigned)(na + nadd) & 15u) << (8 * j); wv |= ((unsigned)(nb + nadd) & 15u) << (8 * j); }
                wu <<= nsh; wv <<= nsh;
                const unsigned got = (unsigned)__builtin_amdgcn_update_dpp(0, (int)(odd ? wu : wv), 0xB1, 0xf, 0xf, false);
                const unsigned word = (odd ? wv : wu) | got;
                *(unsigned*)(ws + (odd ? WS_PV4 : WS_PU4) + ((size_t)((k & 3) * 16384 + 2 * it + (k >> 2))) * 128 + (lane >> 1) * 4) = word; }
        }
    }
#endif
    xcd_barrier(bar);
#endif
#if DEBUG_STAGE >= 9
    GEMM((const bf16*)(ws + WS_HB), nullptr, (const bf16*)(ws + WS_W1), nullptr, 1024, 1024, 1024, 128, 8, 1, pg8::ORD_STD, pg8::EK_PS2, 0, 0, 0, 0);
    xcd_barrier(bar);
    if (REP & 16) peer_topk(ws, L + wave * 16384, gw, NGW, FRESH_LANE());
    peer_topk(ws, L + wave * 16384, gw, NGW, FRESH_LANE());
    xcd_barrier(bar);
    { const bool xp = (G % 8 == 0); const int np = xp ? 1 : 4, wvp = xp ? ((bx >> 3) * 2 + (bx & 1)) * NWAVES + wave : gw, nwp = xp ? (G >> 2) * NWAVES : NGW;
      for (int p_ = 0; p_ < np * ((REP & 32) ? 2 : 1); ++p_) peer_u4_pass(ws, xp ? ((bx & 7) >> 1) : (p_ & 3), wvp, nwp, FRESH_LANE()); }
    xcd_barrier(bar);
    peer_combine(ws, bx * 512 + wave * 64 + FRESH_LANE(), G * 512);
    xcd_barrier(bar);
    { const bool xp = (G % 8 == 0); const int np = xp ? 1 : 4, wvp = xp ? ((bx >> 3) * 2 + (bx & 1)) * NWAVES + wave : gw, nwp = xp ? (G >> 2) * NWAVES : NGW;
      for (int p_ = 0; p_ < np * ((REP & 64) ? 2 : 1); ++p_) peer_v4_pass(ws, xp ? ((bx & 7) >> 1) : (p_ & 3), wvp, nwp, FRESH_LANE()); }
    xcd_barrier(bar);
    { const int lane = FRESH_LANE();
    for (int m = gw; m < NTOK; m += NGW) final_norm_row((const bf16*)(ws + WS_HB) + (size_t)m * 1024, (const _Float16*)(ws + WS_POUT) + (size_t)m * 1024, (const float*)args.in[31], args.out + (size_t)m * 1024, lane); }
#else
    {
        const float* src = (DEBUG_STAGE == 0) ? x : (const float*)(ws + WS_H); const int lane = FRESH_LANE();
        for (int m = gw; m < NTOK; m += NGW) rms_row_to_f32(src + (size_t)m * 1024, (const float*)args.in[31], args.out + (size_t)m * 1024, lane);
    }
#endif
#undef GEMM
#undef GEMMC
}

extern "C" void kernel_launch(void* const* d_in, const int* in_sizes, int n_in, void* d_out, int out_size, void* d_ws, size_t ws_size, hipStream_t stream) {
    static int grid = 0;
    if (grid == 0) {
        if (n_in != 32 || in_sizes[0] != NTOK * D || out_size != NTOK * D || ws_size < WS_END) {
            fprintf(stderr, "kernel_launch: unexpected shapes: n_in %d in0 %d out %d ws %zu (need %zu)\n", n_in, n_in > 0 ? in_sizes[0] : -1, out_size, ws_size, (size_t)WS_END); grid = -1; return; }
        int dev = 0, cus = 0, per_cu = 0;
        if (hipGetDevice(&dev) != hipSuccess || hipDeviceGetAttribute(&cus, hipDeviceAttributeMultiprocessorCount, dev) != hipSuccess) { grid = -1; return; }
        if (hipFuncSetAttribute((const void*)fwd_megakernel, hipFuncAttributeMaxDynamicSharedMemorySize, LDS_BYTES) != hipSuccess) { fprintf(stderr, "kernel_launch: hipFuncSetAttribute failed\n"); grid = -1; return; }
        if (hipOccupancyMaxActiveBlocksPerMultiprocessor(&per_cu, (const void*)fwd_megakernel, NWAVES * 64, LDS_BYTES) != hipSuccess || per_cu < 1) {
            fprintf(stderr, "kernel_launch: occupancy query reports %d blocks per CU\n", per_cu); per_cu = 1; }
        (void)hipGetLastError();
        grid = cus;
    }
    if (grid < 0) return;
    if (hipMemsetAsync((char*)d_ws + WS_CTL, 0, CTL_ZERO_BYTES, stream) != hipSuccess) { fprintf(stderr, "kernel_launch: memset failed\n"); return; }
    Args a{};
    for (int i = 0; i < 32; ++i) a.in[i] = d_in[i];
    a.out = (float*)d_out; a.ws = (unsigned char*)d_ws;
    void* kargs[] = {&a};
    hipError_t e = hipLaunchCooperativeKernel((const void*)fwd_megakernel, dim3(grid), dim3(NWAVES * 64), kargs, LDS_BYTES, stream);
    if (e != hipSuccess) fprintf(stderr, "kernel_launch: cooperative launch failed: %s (grid %d)\n", hipGetErrorString(e), grid);
}
```
